# Optimizing an MI355X kernel written in HIP

```python
import jax, jax.numpy as jnp
from jax import lax
import numpy as np

D_MODEL = 1024
BATCH = 1
SEQ = 16384
DEPTH = 1
DEC_BATCH = 32
DEC_SEQ = 32
PAST_LEN = 1024

CHUNK = 64
POOL_WIDTH = 512
POOL_WINDOWS = (2, 4, 8, 16)
POOL_GROUPS = len(POOL_WINDOWS)
POOL_GROUP_DIM = POOL_WIDTH // POOL_GROUPS
POOL_STATE = max(POOL_WINDOWS) - 1
FOX_HEADS = 8
HEAD_DIM = 64
FOX_WIDTH = FOX_HEADS * HEAD_DIM
N_BRANCHES = 2
D_IN = POOL_WIDTH + 3 * FOX_WIDTH + FOX_HEADS + N_BRANCHES * D_MODEL
D_FF = -(-8 * D_MODEL // (3 * 256)) * 256
Q_BLOCK = 128
EPS = 1e-6
NEG_INF = -1e30

kernel_name = "hybrid_pool_fox_streaming_step"


def rmsnorm(x, g):
    xf = x.astype(jnp.float32)
    y = xf * lax.rsqrt(jnp.mean(xf * xf, axis=-1, keepdims=True) + EPS)
    return (y * g.astype(jnp.float32)).astype(x.dtype)


def project_in(xn, w_in):
    z = xn @ w_in
    b, t = z.shape[0], z.shape[1]
    idx = [POOL_WIDTH, POOL_WIDTH + FOX_WIDTH, POOL_WIDTH + 2 * FOX_WIDTH,
           POOL_WIDTH + 3 * FOX_WIDTH, POOL_WIDTH + 3 * FOX_WIDTH + FOX_HEADS]
    p, q, k, v, fl, gl = jnp.split(z, idx, axis=-1)
    q = q.reshape(b, t, FOX_HEADS, HEAD_DIM)
    k = k.reshape(b, t, FOX_HEADS, HEAD_DIM)
    v = v.reshape(b, t, FOX_HEADS, HEAD_DIM)
    return p, q, k, v, fl, gl


def pool_mixer(p_ext, pos0, w_group, pool_scale):
    b = p_ext.shape[0]
    t = p_ext.shape[1] - POOL_STATE
    pf = p_ext.astype(jnp.float32)
    cs = jnp.cumsum(pf, axis=1)
    cs = jnp.concatenate([jnp.zeros_like(cs[:, :1]), cs], axis=1)
    end = cs[:, POOL_STATE + 1:]
    pos = pos0 + jnp.arange(t)
    outs = []
    for g, w in enumerate(POOL_WINDOWS):
        lo, hi = g * POOL_GROUP_DIM, (g + 1) * POOL_GROUP_DIM
        start = cs[:, POOL_STATE + 1 - w: POOL_STATE + 1 - w + t, lo:hi]
        cnt = jnp.minimum(w, pos + 1).astype(jnp.float32)[None, :, None]
        outs.append((end[..., lo:hi] - start) / cnt)
    pooled = jnp.concatenate(outs, axis=-1)
    d = (pooled - pf[:, POOL_STATE:]).reshape(b, t, POOL_GROUPS, POOL_GROUP_DIM)
    mixed = jnp.einsum('btgc,gcd->btgd', d, w_group.astype(jnp.float32)).reshape(b, t, POOL_WIDTH)
    return (mixed * pool_scale.astype(jnp.float32)).astype(p_ext.dtype)


def fox_attend(q, k, v, cq, ck, qpos, kpos):
    logits = jnp.einsum('bqhd,bkhd->bhqk', q, k).astype(jnp.float32) * (HEAD_DIM ** -0.5)
    bias = jnp.transpose(cq, (0, 2, 1))[..., :, None] - jnp.transpose(ck, (0, 2, 1))[..., None, :]
    mask = kpos[None, :] <= qpos[:, None]
    logits = jnp.where(mask, logits + bias, NEG_INF)
    probs = jax.nn.softmax(logits, axis=-1)
    return jnp.einsum('bhqk,bkhd->bqhd', probs.astype(v.dtype), v)


def fox_prompt(q, k, v, logf):
    b, s = q.shape[0], q.shape[1]
    c = jnp.cumsum(logf.astype(jnp.float32), axis=1)
    kpos = jnp.arange(s)

    def block(i):
        s0 = i * Q_BLOCK
        qb = lax.dynamic_slice_in_dim(q, s0, Q_BLOCK, axis=1)
        cq = lax.dynamic_slice_in_dim(c, s0, Q_BLOCK, axis=1)
        qpos = s0 + jnp.arange(Q_BLOCK)
        return fox_attend(qb, k, v, cq, c, qpos, kpos)

    out = lax.map(block, jnp.arange(s // Q_BLOCK))
    return jnp.transpose(out, (1, 0, 2, 3, 4)).reshape(b, s, FOX_HEADS, HEAD_DIM)


def fox_sample(q, k, v, logf, cache_k, cache_v, cache_logf):
    past = cache_k.shape[1]
    t = q.shape[1]
    k_all = jnp.concatenate([cache_k.astype(k.dtype), k], axis=1)
    v_all = jnp.concatenate([cache_v.astype(v.dtype), v], axis=1)
    logf_all = jnp.concatenate([cache_logf.astype(jnp.float32), logf.astype(jnp.float32)], axis=1)
    c = jnp.cumsum(logf_all, axis=1)
    qpos = past + jnp.arange(t)
    kpos = jnp.arange(past + t)
    return fox_attend(q, k_all, v_all, c[:, past:], c, qpos, kpos)


def merge_branches(o_pool, o_attn, gate_logits, w_branch_pool, w_branch_attn, b_gate, w_out):
    g = jax.nn.sigmoid(gate_logits + b_gate)
    g_pool, g_attn = jnp.split(g, N_BRANCHES, axis=-1)
    b, t = o_attn.shape[0], o_attn.shape[1]
    merged = g_pool * (o_pool @ w_branch_pool) + g_attn * (o_attn.reshape(b, t, FOX_WIDTH) @ w_branch_attn)
    return merged @ w_out


def swiglu(x, w_gate, w_up, w_down):
    return (jax.nn.silu(x @ w_gate) * (x @ w_up)) @ w_down


def setup_inputs(seed: int = 0) -> dict:
    key = jax.random.key(seed)
    ks = jax.random.split(key, 24)
    f32 = jnp.float32
    nrm = lambda k, shape, scale: jax.random.normal(k, shape, f32) * scale
    return {
        "x_prompt": nrm(ks[0], (BATCH, SEQ, D_MODEL), 1.0),
        "x_sample": nrm(ks[1], (DEC_BATCH, DEC_SEQ, D_MODEL), 1.0),
        "cache_k": nrm(ks[2], (DEPTH, DEC_BATCH, PAST_LEN, FOX_HEADS, HEAD_DIM), 1.0),
        "cache_v": nrm(ks[3], (DEPTH, DEC_BATCH, PAST_LEN, FOX_HEADS, HEAD_DIM), 1.0),
        "cache_logf": jax.nn.log_sigmoid(2.0 + nrm(ks[4], (DEPTH, DEC_BATCH, PAST_LEN, FOX_HEADS), 1.0)),
        "state_pool": nrm(ks[5], (DEPTH, DEC_BATCH, POOL_STATE, POOL_WIDTH), 1.0),
        "norm_mix": 1.0 + nrm(ks[6], (DEPTH, D_MODEL), 0.02),
        "w_in": nrm(ks[7], (DEPTH, D_MODEL, D_IN), D_MODEL ** -0.5),
        "b_forget": 2.0 + nrm(ks[8], (DEPTH, FOX_HEADS), 0.1),
        "w_pool_group": nrm(ks[9], (DEPTH, POOL_GROUPS, POOL_GROUP_DIM, POOL_GROUP_DIM), POOL_GROUP_DIM ** -0.5),
        "pool_scale": 1.0 + nrm(ks[10], (DEPTH, POOL_WIDTH), 0.1),
        "w_branch_pool": nrm(ks[11], (DEPTH, POOL_WIDTH, D_MODEL), POOL_WIDTH ** -0.5),
        "w_branch_attn": nrm(ks[12], (DEPTH, FOX_WIDTH, D_MODEL), FOX_WIDTH ** -0.5),
        "b_gate": nrm(ks[13], (DEPTH, N_BRANCHES * D_MODEL), 0.02),
        "w_out": nrm(ks[14], (DEPTH, D_MODEL, D_MODEL), D_MODEL ** -0.5),
        "norm_ffn": 1.0 + nrm(ks[15], (DEPTH, D_MODEL), 0.02),
        "w_ffn_gate": nrm(ks[16], (DEPTH, D_MODEL, D_FF), D_MODEL ** -0.5),
        "w_ffn_up": nrm(ks[17], (DEPTH, D_MODEL, D_FF), D_MODEL ** -0.5),
        "w_ffn_down": nrm(ks[18], (DEPTH, D_FF, D_MODEL), D_FF ** -0.5),
        "norm_final": 1.0 + nrm(ks[19], (D_MODEL,), 0.02),
    }


def reference(x_prompt, x_sample, cache_k, cache_v, cache_logf, state_pool, norm_mix, w_in, b_forget,
              w_pool_group, pool_scale, w_branch_pool, w_branch_attn, b_gate, w_out, norm_ffn,
              w_ffn_gate, w_ffn_up, w_ffn_down, norm_final):
    xp, xs = x_prompt, x_sample
    kp_l, vp_l, fp_l, pp_l, ks_l, vs_l, fs_l, ps_l = [], [], [], [], [], [], [], []
    for l in range(DEPTH):
        xn = rmsnorm(xp, norm_mix[l])
        p, q, k, v, fl, gl = project_in(xn, w_in[l])
        logf = jax.nn.log_sigmoid((fl + b_forget[l]).astype(jnp.float32))
        p_ext = jnp.concatenate([jnp.zeros((p.shape[0], POOL_STATE, POOL_WIDTH), p.dtype), p], axis=1)
        o_pool = pool_mixer(p_ext, 0, w_pool_group[l], pool_scale[l])
        o_attn = fox_prompt(q, k, v, logf)
        xp = xp + merge_branches(o_pool, o_attn, gl, w_branch_pool[l], w_branch_attn[l], b_gate[l], w_out[l])
        xp = xp + swiglu(rmsnorm(xp, norm_ffn[l]), w_ffn_gate[l], w_ffn_up[l], w_ffn_down[l])
        kp_l.append(k)
        vp_l.append(v)
        fp_l.append(logf)
        pp_l.append(p_ext[:, -POOL_STATE:])

        past = cache_k.shape[2]
        xn = rmsnorm(xs, norm_mix[l])
        p, q, k, v, fl, gl = project_in(xn, w_in[l])
        logf = jax.nn.log_sigmoid((fl + b_forget[l]).astype(jnp.float32))
        p_ext = jnp.concatenate([state_pool[l].astype(p.dtype), p], axis=1)
        o_pool = pool_mixer(p_ext, past, w_pool_group[l], pool_scale[l])
        o_attn = fox_sample(q, k, v, logf, cache_k[l], cache_v[l], cache_logf[l])
        xs = xs + merge_branches(o_pool, o_attn, gl, w_branch_pool[l], w_branch_attn[l], b_gate[l], w_out[l])
        xs = xs + swiglu(rmsnorm(xs, norm_ffn[l]), w_ffn_gate[l], w_ffn_up[l], w_ffn_down[l])
        ks_l.append(k)
        vs_l.append(v)
        fs_l.append(logf)
        ps_l.append(p_ext[:, -POOL_STATE:])

    y_prompt = rmsnorm(xp, norm_final)
    y_sample = rmsnorm(xs, norm_final)
    return (y_prompt, y_sample,
            jnp.stack(kp_l), jnp.stack(vp_l), jnp.stack(fp_l), jnp.stack(pp_l),
            jnp.stack(ks_l), jnp.stack(vs_l), jnp.stack(fs_l), jnp.stack(ps_l))
```

```cpp
#include <hip/hip_runtime.h>
#include <hip/hip_cooperative_groups.h>
#include <cstdio>
#include <cstdint>
namespace cg = cooperative_groups;

#define LAS __attribute__((address_space(3)))
typedef unsigned short bf16_t;
typedef short bf16x8 __attribute__((ext_vector_type(8)));
typedef float f32x4 __attribute__((ext_vector_type(4)));
typedef float f32x2 __attribute__((ext_vector_type(2)));
typedef float f32x16 __attribute__((ext_vector_type(16)));
typedef unsigned u32x4 __attribute__((ext_vector_type(4)));
typedef unsigned u32x2 __attribute__((ext_vector_type(2)));
typedef __bf16 bf16x2_t __attribute__((ext_vector_type(2)));

constexpr int DM = 1024, SEQ = 16384, NSAMP = 1024, MROWS = SEQ + NSAMP;
constexpr int PAST = 1024, NH = 8, DIN = 4104, DFF = 2816;
constexpr float EPS = 1e-6f, LOG2E = 1.4426950408889634f, C2 = 0.125f * 1.4426950408889634f;
constexpr size_t O_Y = 0, O_KP = 17825792, O_VP = 26214400, O_LFP = 34603008, O_POOLP = 34734080, O_KS = 34741760, O_VS = 35266048,
                 O_LFS = 35790336, O_POOLS = 35798528;
constexpr size_t MiB = 1u << 20;
constexpr size_t WS_CTL = 0;
constexpr size_t CTL_HNQ = 0, CTL_HNK = 16384, CTL_RSS1 = 32768, CTL_RSS2 = 32768 + 81920, CTL_CTR = 32768 + 2 * 81920, CTL_ZERO_END = CTL_CTR + 256;
constexpr size_t WS_BAR = 208 * 1024;
constexpr size_t WS_TT = 256 * 1024;
constexpr size_t WS_LH = 384 * 1024;
constexpr size_t WS_W1 = 1 * MiB;
constexpr size_t WS_WBP = 9 * MiB, WS_WBA = 10 * MiB, WS_WO = 11 * MiB;
constexpr size_t WS_WGU = 13 * MiB;
constexpr size_t WS_WD = 24 * MiB;
constexpr size_t WS_WPG = 30 * MiB;
constexpr size_t WS_XN = 32 * MiB;
constexpr size_t WS_G = 66 * MiB;
constexpr size_t WS_P = 134 * MiB;
constexpr size_t WS_Q = 168 * MiB, WS_K = 185 * MiB, WS_V = 201 * MiB;
constexpr size_t WS_OP = 217 * MiB, WS_OA = 234 * MiB;
constexpr size_t WS_T = 134 * MiB;
constexpr size_t WS_KX = 251 * MiB;
constexpr size_t WS_HF = 100 * MiB;

__device__ __forceinline__ unsigned cvtpk(float lo, float hi) { f32x2 v = {lo, hi}; bf16x2_t b = __builtin_convertvector(v, bf16x2_t); return __builtin_bit_cast(unsigned, b); }
__device__ __forceinline__ unsigned short cvt1(float x) { return (unsigned short)(cvtpk(x, 0.f) & 0xffffu); }
__device__ __forceinline__ float bf2f(unsigned short b) { return __uint_as_float(((unsigned)b) << 16); }
__device__ __forceinline__ int crow(int r, int hi) { return (r & 3) + 8 * (r >> 2) + 4 * hi; }
__device__ __forceinline__ float wave_sum(float v) {
#pragma unroll
    for (int o = 1; o < 64; o <<= 1) v += __shfl_xor(v, o);
    return v;
}
__device__ __forceinline__ float wave_max(float v) {
#pragma unroll
    for (int o = 1; o < 64; o <<= 1) v = fmaxf(v, __shfl_xor(v, o));
    return v;
}

namespace pg8 {
constexpr int BM = 256, BK = 64, HALF = 128, HTB = HALF * BK * 2, STAGE_BYTES = 8 * HTB, NXCD = 8, WGM = 8;
__host__ __device__ __forceinline__ int lds_byte(int r, int c) { const int st = (r >> 4) * 2 + (c >> 5), rr = r & 15, cc = c & 31, ob = rr * 64 + cc * 2; return st * 1024 + (ob ^ (((ob >> 9) & 1) << 5)); }
__host__ __device__ __forceinline__ void stage_rc(int b, int& R, int& C) { const int st = b / 1024, sb = b % 1024, swz = sb ^ (((sb >> 9) & 1) << 5); R = (st >> 1) * 16 + swz / 64; C = (st & 1) * 32 + (swz % 64) / 2; }
__host__ __device__ __forceinline__ int perm32(int rho) { const int n = rho >> 4, i = rho & 15; return 8 * (i >> 2) + 4 * n + (i & 3); }
struct Unit { int pm, pn, k0, nk, sel; };
struct Gemm { const bf16_t* A; const bf16_t* Bt; int M, N, K; const bf16_t* A2; const bf16_t* B2; };
struct StaticOrder {
    int nM, nN, nwg, G, c, nkf;
    __host__ __device__ __forceinline__ void init(int M, int N, int G_, int c_, int K_) { nM = M / BM; nN = N / BM; nwg = nM * nN; G = G_; c = c_; nkf = K_ / BK; }
    __host__ __device__ __forceinline__ bool next(int i, Unit& u) const {
        const long L = (long)i * G + c; if (L >= nwg) return false;
        int wgid = (int)L; { const int q = nwg / NXCD, r = nwg % NXCD, xcd = wgid % NXCD, off = wgid / NXCD; wgid = (xcd < r ? xcd * (q + 1) : r * (q + 1) + (xcd - r) * q) + off; }
        const int nig = WGM * nN, gid = wgid / nig, fm = gid * WGM, gsz = (nM - fm) < WGM ? (nM - fm) : WGM;
        u.pm = fm + ((wgid % nig) % gsz); u.pn = (wgid % nig) / gsz; u.k0 = 0; u.nk = nkf; u.sel = 0; return true;
    }
    __device__ __forceinline__ void a_ready(const Unit&) const {}
    __device__ __forceinline__ void done(const Unit&) const {}
};

template <class Epi, class Sched, bool ALIGN_EPI = false, bool SP2 = false>
__device__ __forceinline__ void gemm_phase(LAS unsigned char* lds, const Gemm g, const Sched& S, const Epi& E) {
    const int tid = threadIdx.x, wid = __builtin_amdgcn_readfirstlane(tid >> 6), lane = tid & 63, wr = wid >> 2, wc = wid & 3, fr = lane & 15, fq = lane >> 4;
    const int K = g.K;
    unsigned voffA[2], voffB[2];
#pragma unroll
    for (int i = 0; i < 2; ++i) { int R, C; stage_rc(tid * 16 + i * 8192, R, C); const int Rb = Epi::PERM ? ((R & ~31) + perm32(R & 31)) : R;
        voffA[i] = (unsigned)(R * K + C) * 2u; voffB[i] = (unsigned)(Rb * K + C) * 2u; }
    const size_t kstep = (size_t)(BK * 2);
    const size_t hstep = (size_t)HALF * K * 2;
    const size_t tstep = 2 * hstep;
    const unsigned ldsw = (unsigned)wid * 1024u;
    const int aoff = lds_byte(wr * 64 + fr, fq * 8), boff = lds_byte(wc * 32 + fr, fq * 8);
#define PG8_SA(b, h) (((b) * 2 + (h)) * HTB)
#define PG8_SB(b, h) ((4 + (b) * 2 + (h)) * HTB)
#define PG8_STAGE(bufoff, gbase, voff) do { _Pragma("unroll") for (int _i = 0; _i < 2; ++_i) \
        __builtin_amdgcn_global_load_lds((const unsigned*)((const char*)(gbase) + (voff)[_i]), (LAS unsigned*)(lds + (bufoff) + ldsw + _i * 8192), 16, 0, 0); } while (0)
#define PG8_LDA(dst, b, h) do { _Pragma("unroll") for (int m = 0; m < 4; ++m) _Pragma("unroll") for (int k = 0; k < 2; ++k) dst[m][k] = *(const LAS bf16x8*)(lds + PG8_SA(b, h) + aoff + m * 2048 + k * 1024); } while (0)
#define PG8_LDB(dst, b, h) do { _Pragma("unroll") for (int n = 0; n < 2; ++n) _Pragma("unroll") for (int k = 0; k < 2; ++k) dst[n][k] = *(const LAS bf16x8*)(lds + PG8_SB(b, h) + boff + n * 2048 + k * 1024); } while (0)
#define PG8_MMA(ai, bj, At, Bt) do { __builtin_amdgcn_s_setprio(1); _Pragma("unroll") for (int m = 0; m < 4; ++m) _Pragma("unroll") for (int n = 0; n < 2; ++n) _Pragma("unroll") for (int k = 0; k < 2; ++k) \
        acc[ai][bj][m][n] = __builtin_amdgcn_mfma_f32_16x16x32_bf16(Bt[n][k], At[m][k], acc[ai][bj][m][n], 0, 0, 0); __builtin_amdgcn_s_setprio(0); } while (0)
#define PG8_WAIT_V(n) asm volatile("s_waitcnt vmcnt(" #n ")" ::: "memory")
#define PG8_WAIT_L(n) asm volatile("s_waitcnt lgkmcnt(" #n ")" ::: "memory")
#define PG8_BAR __builtin_amdgcn_s_barrier()
#define PG8_SCHED __builtin_amdgcn_sched_barrier(0)
    Unit cur, nxt; int ui = 0;
    if (!S.next(0, cur)) return;
    f32x4 acc[2][2][4][2];
#pragma unroll
    for (int a = 0; a < 2; ++a)
#pragma unroll
        for (int b = 0; b < 2; ++b)
#pragma unroll
            for (int m = 0; m < 4; ++m)
#pragma unroll
                for (int n = 0; n < 2; ++n) acc[a][b][m][n] = (f32x4){0.f, 0.f, 0.f, 0.f};
    bf16x8 At[4][2], B0[2][2], B1[2][2];
    const char* cA = (const char*)(cur.sel ? g.A2 : g.A) + (size_t)cur.pm * tstep + (size_t)cur.k0 * kstep; const char* cB = (const char*)(cur.sel ? g.B2 : g.Bt) + (size_t)cur.pn * tstep + (size_t)cur.k0 * kstep;
    S.a_ready(cur);
    if constexpr (SP2) {
        PG8_STAGE(PG8_SB(0, 0), cB, voffB); PG8_STAGE(PG8_SB(0, 1), cB + hstep, voffB); PG8_STAGE(PG8_SA(0, 0), cA, voffA); PG8_STAGE(PG8_SA(0, 1), cA + hstep, voffA);
        if (wr == 1) PG8_BAR;
        PG8_WAIT_V(2); PG8_BAR;
        PG8_STAGE(PG8_SB(1, 0), cB + kstep, voffB); PG8_STAGE(PG8_SA(1, 0), cA + kstep, voffA); PG8_STAGE(PG8_SB(1, 1), cB + hstep + kstep, voffB);
        PG8_WAIT_V(6); PG8_BAR;
    } else {
        PG8_STAGE(PG8_SB(0, 0), cB, voffB); PG8_STAGE(PG8_SA(0, 0), cA, voffA); PG8_STAGE(PG8_SB(0, 1), cB + hstep, voffB); PG8_STAGE(PG8_SA(0, 1), cA + hstep, voffA);
        if (wr == 1) PG8_BAR;
        PG8_WAIT_V(4); PG8_BAR;
        PG8_STAGE(PG8_SB(1, 0), cB + kstep, voffB); PG8_STAGE(PG8_SA(1, 0), cA + kstep, voffA); PG8_STAGE(PG8_SB(1, 1), cB + hstep + kstep, voffB);
        PG8_WAIT_V(6); PG8_BAR;
    }
    for (;;) {
        const bool has_next = S.next(ui + 1, nxt);
        const char* nA = has_next ? (const char*)(nxt.sel ? g.A2 : g.A) + (size_t)nxt.pm * tstep + (size_t)nxt.k0 * kstep : cA; const char* nB = has_next ? (const char*)(nxt.sel ? g.B2 : g.Bt) + (size_t)nxt.pn * tstep + (size_t)nxt.k0 * kstep : cB;
        const int nt = cur.nk;
        for (int t = 0; t < nt; t += 2) {
            const bool last = (t == nt - 2);
            const char* a1 = cA + (size_t)(t + 1) * kstep;
            const char* a2 = last ? nA : cA + (size_t)(t + 2) * kstep; const char* b2 = last ? nB : cB + (size_t)(t + 2) * kstep;
            const char* a3 = a2 + kstep; const char* b3 = b2 + kstep;
            if (last && has_next) S.a_ready(nxt);
            if constexpr (SP2) {
            PG8_LDB(B0, 0, 0); PG8_LDB(B1, 0, 1); PG8_SCHED; PG8_LDA(At, 0, 0); PG8_STAGE(PG8_SA(1, 1), a1 + hstep, voffA);
            PG8_WAIT_V(8); PG8_WAIT_L(0); PG8_BAR; PG8_MMA(0, 0, At, B0); PG8_MMA(0, 1, At, B1); PG8_BAR; PG8_SCHED;
            PG8_LDA(At, 0, 1); PG8_STAGE(PG8_SB(0, 0), b2, voffB); PG8_STAGE(PG8_SB(0, 1), b2 + hstep, voffB); PG8_STAGE(PG8_SA(0, 0), a2, voffA);
            PG8_WAIT_V(8); PG8_WAIT_L(0); PG8_BAR; PG8_MMA(1, 0, At, B0); PG8_MMA(1, 1, At, B1); PG8_BAR; PG8_SCHED;
            PG8_LDB(B0, 1, 0); PG8_LDB(B1, 1, 1); PG8_SCHED; PG8_LDA(At, 1, 0); PG8_STAGE(PG8_SA(0, 1), a2 + hstep, voffA);
            PG8_WAIT_V(8); PG8_WAIT_L(0); PG8_BAR; PG8_MMA(0, 0, At, B0); PG8_MMA(0, 1, At, B1); PG8_BAR; PG8_SCHED;
            PG8_LDA(At, 1, 1); PG8_STAGE(PG8_SB(1, 0), b3, voffB); PG8_STAGE(PG8_SB(1, 1), b3 + hstep, voffB); PG8_STAGE(PG8_SA(1, 0), a3, voffA);
            PG8_WAIT_V(8); PG8_WAIT_L(0); PG8_BAR; PG8_MMA(1, 0, At, B0); PG8_MMA(1, 1, At, B1); PG8_BAR; PG8_SCHED;
            } else {
            PG8_LDB(B0, 0, 0); PG8_SCHED; PG8_LDA(At, 0, 0); PG8_STAGE(PG8_SA(1, 1), a1 + hstep, voffA);
            PG8_WAIT_L(8); PG8_BAR; PG8_WAIT_L(0); PG8_MMA(0, 0, At, B0); PG8_BAR; PG8_SCHED;
            PG8_LDB(B1, 0, 1); PG8_STAGE(PG8_SB(0, 0), b2, voffB);
            PG8_BAR; PG8_WAIT_L(0); PG8_MMA(0, 1, At, B1); PG8_BAR;
            PG8_LDA(At, 0, 1); PG8_STAGE(PG8_SA(0, 0), a2, voffA);
            PG8_BAR; PG8_WAIT_L(0); PG8_MMA(1, 0, At, B0); PG8_BAR; PG8_SCHED;
            PG8_STAGE(PG8_SB(0, 1), b2 + hstep, voffB);
            PG8_WAIT_V(6); PG8_BAR; PG8_MMA(1, 1, At, B1); PG8_BAR;
            PG8_LDB(B0, 1, 0); PG8_SCHED; PG8_LDA(At, 1, 0); PG8_STAGE(PG8_SA(0, 1), a2 + hstep, voffA);
            PG8_WAIT_L(8); PG8_BAR; PG8_WAIT_L(0); PG8_MMA(0, 0, At, B0); PG8_BAR; PG8_SCHED;
            PG8_LDB(B1, 1, 1); PG8_STAGE(PG8_SB(1, 0), b3, voffB);
            PG8_BAR; PG8_WAIT_L(0); PG8_MMA(0, 1, At, B1); PG8_BAR;
            PG8_LDA(At, 1, 1); PG8_STAGE(PG8_SA(1, 0), a3, voffA);
            PG8_BAR; PG8_WAIT_L(0); PG8_MMA(1, 0, At, B0); PG8_BAR; PG8_SCHED;
            PG8_STAGE(PG8_SB(1, 1), b3 + hstep, voffB);
            PG8_WAIT_V(6); PG8_BAR; PG8_MMA(1, 1, At, B1); PG8_BAR;
            }
        }
        if constexpr (ALIGN_EPI) { if (wr == 0) PG8_BAR; }
        E(acc, cur, wr, wc, fr, fq); S.done(cur);
        if (!has_next) break;
#pragma unroll
        for (int a = 0; a < 2; ++a)
#pragma unroll
            for (int b = 0; b < 2; ++b)
#pragma unroll
                for (int m = 0; m < 4; ++m)
#pragma unroll
                    for (int n = 0; n < 2; ++n) acc[a][b][m][n] = (f32x4){0.f, 0.f, 0.f, 0.f};
        cur = nxt; cA = nA; cB = nB; ++ui;
        if constexpr (ALIGN_EPI) { if (wr == 1) PG8_BAR; }
    }
    PG8_WAIT_V(0);
    if constexpr (!ALIGN_EPI) { if (wr == 0) PG8_BAR; }
    PG8_BAR;
#undef PG8_SA
#undef PG8_SB
#undef PG8_STAGE
#undef PG8_LDA
#undef PG8_LDB
#undef PG8_MMA
#undef PG8_WAIT_V
#undef PG8_WAIT_L
#undef PG8_BAR
#undef PG8_SCHED
}
}

typedef const f32x4 (&AccRef)[2][2][4][2];
__device__ __forceinline__ u32x4 pack8(f32x4 a, f32x4 b) { u32x4 w; w.x = cvtpk(a[0], a[1]); w.y = cvtpk(a[2], a[3]); w.z = cvtpk(b[0], b[1]); w.w = cvtpk(b[2], b[3]); return w; }
__device__ __forceinline__ float sigm(float x) { return __builtin_amdgcn_rcpf(1.0f + __builtin_amdgcn_exp2f(-1.4426950408889634f * x)); }
__device__ __forceinline__ void unpack8(u32x4 w, float* g) {
    g[0] = __uint_as_float(w.x << 16); g[1] = __uint_as_float(w.x & 0xffff0000u); g[2] = __uint_as_float(w.y << 16); g[3] = __uint_as_float(w.y & 0xffff0000u);
    g[4] = __uint_as_float(w.z << 16); g[5] = __uint_as_float(w.z & 0xffff0000u); g[6] = __uint_as_float(w.w << 16); g[7] = __uint_as_float(w.w & 0xffff0000u);
}

struct Epi1 {
    static constexpr bool PERM = true, AFTER_DRAIN = false;
    float* P; bf16_t* Qb; bf16_t* Kb; bf16_t* Vt; bf16_t* G; const float* b_gate; float* out; unsigned* hnQ; unsigned* hnK;
    __device__ __forceinline__ void operator()(AccRef acc, const pg8::Unit& u, int wr, int wc, int fr, int fq) const {
        const int kind = u.pn; const bool prompt = u.pm < 64;
        const int cb = wc * 32 + 8 * fq;
        if (kind < 2) {
#pragma unroll
            for (int ai = 0; ai < 2; ++ai)
#pragma unroll
                for (int m = 0; m < 4; ++m) {
                    const int row = u.pm * 256 + ai * 128 + wr * 64 + m * 16 + fr;
                    float* po = nullptr;
                    if (prompt) { if (row >= SEQ - 15) po = out + O_POOLP + (size_t)(row - (SEQ - 15)) * 512; }
                    else { const int rs = row - SEQ, t = rs & 31; if (t >= 17) po = out + O_POOLS + (size_t)((rs >> 5) * 15 + t - 17) * 512; }
#pragma unroll
                    for (int bj = 0; bj < 2; ++bj) {
                        const int lc = kind * 256 + bj * 128 + cb;
                        float* dst = P + (size_t)row * 512 + lc;
                        *(f32x4*)dst = acc[ai][bj][m][0]; *(f32x4*)(dst + 4) = acc[ai][bj][m][1];
                        if (po) { *(f32x4*)(po + lc) = acc[ai][bj][m][0]; *(f32x4*)(po + lc + 4) = acc[ai][bj][m][1]; }
                    }
                }
        } else if (kind < 6) {
            const bool isq = kind < 4;
            const int base = isq ? 512 : 1024;
            const float sc = isq ? C2 : 1.0f;
            float* fo = prompt ? out + O_KP : out + O_KS - (size_t)SEQ * 512;
#pragma unroll
            for (int ai = 0; ai < 2; ++ai)
#pragma unroll
                for (int bj = 0; bj < 2; ++bj) {
                    const int lc = kind * 256 - base + bj * 128 + cb;
                    float mx = 0.f;
#pragma unroll
                    for (int m = 0; m < 4; ++m) {
                        const int row = u.pm * 256 + ai * 128 + wr * 64 + m * 16 + fr;
                        const f32x4 v0 = acc[ai][bj][m][0] * sc, v1 = acc[ai][bj][m][1] * sc;
                        if (isq) { *(u32x4*)(Qb + (size_t)row * 512 + lc) = pack8(v0, v1); }
                        else {
                            float* d = fo + (size_t)row * 512 + lc; __builtin_nontemporal_store(v0, (f32x4*)d); __builtin_nontemporal_store(v1, (f32x4*)(d + 4));
                            if (prompt) *(u32x4*)(Kb + (size_t)row * 512 + lc) = pack8(v0, v1);
                        }
                        float s = (v0[0] * v0[0] + v0[1] * v0[1]) + (v0[2] * v0[2] + v0[3] * v0[3]) + (v1[0] * v1[0] + v1[1] * v1[1]) + (v1[2] * v1[2] + v1[3] * v1[3]);
                        s += __shfl_xor(s, 16); s += __shfl_xor(s, 32);
                        mx = fmaxf(mx, s);
                    }
                    if (prompt) {
                        mx = fmaxf(mx, __shfl_xor(mx, 1)); mx = fmaxf(mx, __shfl_xor(mx, 2)); mx = fmaxf(mx, __shfl_xor(mx, 4)); mx = fmaxf(mx, __shfl_xor(mx, 8));
                        const int colbase = kind * 256 - base + bj * 128 + wc * 32;
                        if (fr == 0 && fq == 0) atomicMax((isq ? hnQ : hnK) + ((2 * u.pm + ai) * 8 + (colbase >> 6)) * 2 + ((colbase >> 5) & 1), __float_as_uint(mx));
                    }
                }
        } else if (kind < 8) {
            float* fo = prompt ? out + O_VP : out + O_VS - (size_t)SEQ * 512;
#pragma unroll
            for (int ai = 0; ai < 2; ++ai)
#pragma unroll
                for (int m = 0; m < 4; ++m) {
                    const int row = u.pm * 256 + ai * 128 + wr * 64 + m * 16 + fr;
                    const int o16 = row & 15, kvp = (row & 48) + 8 * ((o16 >> 2) & 1) + (o16 & 3) + 4 * (o16 >> 3);
#pragma unroll
                    for (int bj = 0; bj < 2; ++bj) {
                        const int lc = kind * 256 - 1536 + bj * 128 + cb;
                        const f32x4 v0 = acc[ai][bj][m][0], v1 = acc[ai][bj][m][1];
                        float* d = fo + (size_t)row * 512 + lc; __builtin_nontemporal_store(v0, (f32x4*)d); __builtin_nontemporal_store(v1, (f32x4*)(d + 4));
                        if (prompt) {
                            bf16_t* vt = Vt + ((size_t)((lc >> 6) * 256 + (row >> 6)) * 64 + (lc & 63)) * 64 + kvp;
                            vt[0] = cvt1(v0[0]); vt[64] = cvt1(v0[1]); vt[128] = cvt1(v0[2]); vt[192] = cvt1(v0[3]);
                            vt[256] = cvt1(v1[0]); vt[320] = cvt1(v1[1]); vt[384] = cvt1(v1[2]); vt[448] = cvt1(v1[3]);
                        }
                    }
                }
        } else {
#pragma unroll
            for (int bj = 0; bj < 2; ++bj) {
                const int lc = kind * 256 - 2048 + bj * 128 + cb;
                const f32x4 b0 = *(const f32x4*)(b_gate + lc), b1 = *(const f32x4*)(b_gate + lc + 4);
#pragma unroll
                for (int ai = 0; ai < 2; ++ai)
#pragma unroll
                    for (int m = 0; m < 4; ++m) {
                        const int row = u.pm * 256 + ai * 128 + wr * 64 + m * 16 + fr;
                        f32x4 v0 = acc[ai][bj][m][0] + b0, v1 = acc[ai][bj][m][1] + b1;
#pragma unroll
                        for (int e = 0; e < 4; ++e) { v0[e] = sigm(v0[e]); v1[e] = sigm(v1[e]); }
                        *(u32x4*)(G + (size_t)row * 2048 + lc) = pack8(v0, v1);
                    }
            }
        }
    }
};

__device__ __forceinline__ void st_wt64(void* p, unsigned lo, unsigned hi) {
    __hip_atomic_store((unsigned long long*)p, ((unsigned long long)hi << 32) | lo, __ATOMIC_RELAXED, __HIP_MEMORY_SCOPE_AGENT);
}
__device__ __forceinline__ void wait_flag(const unsigned* flag, unsigned want) {
    while (__hip_atomic_load(flag, __ATOMIC_RELAXED, __HIP_MEMORY_SCOPE_AGENT) < want) __builtin_amdgcn_s_sleep(2);
    asm volatile("" ::: "memory");
}
struct Order3a {
    pg8::StaticOrder S0; int G, c;
    __device__ __forceinline__ void init(int G_, int c_) { S0.init(SEQ, 1024, G_, c_, 512); G = G_; c = c_; }
    __device__ __forceinline__ bool next(int i, pg8::Unit& u) const {
        const long L = (long)i * G + c;
        if (L < 256) return S0.next(i, u);
        const int s = (int)L - 256; if (s >= 64) return false;
        const int r = s & 31, id = r >> 1;
        u.pm = 64 + (id >> 2); u.pn = id & 3; u.k0 = 4 * (r & 1); u.nk = 4; u.sel = s >> 5; return true;
    }
    __device__ __forceinline__ void a_ready(const pg8::Unit&) const {}
    __device__ __forceinline__ void done(const pg8::Unit&) const {}
};
template <int PASS> struct Epi3 {
    static constexpr bool PERM = true, AFTER_DRAIN = false;
    bf16_t* T; const bf16_t* G; bf16_t* MG; float* PA;
    __device__ __forceinline__ void operator()(AccRef acc, const pg8::Unit& u, int wr, int wc, int fr, int fq) const {
        const bool samp = (PASS == 0) && (u.pm >= 64);
        float* pa = PA + (size_t)(2 * u.sel + (u.k0 >> 2)) * (NSAMP * 1024) - (size_t)SEQ * 1024;
#pragma unroll
        for (int ai = 0; ai < 2; ++ai)
#pragma unroll
            for (int m = 0; m < 4; ++m) {
                const int row = u.pm * 256 + ai * 128 + wr * 64 + m * 16 + fr;
#pragma unroll
                for (int bj = 0; bj < 2; ++bj) {
                    const int col = u.pn * 256 + bj * 128 + wc * 32 + 8 * fq;
                    f32x4 v0 = acc[ai][bj][m][0], v1 = acc[ai][bj][m][1];
                    if (samp) { float* p = pa + (size_t)row * 1024 + col; *(f32x4*)p = v0; *(f32x4*)(p + 4) = v1; continue; }
                    float g[8]; unpack8(*(const u32x4*)(G + (size_t)row * 2048 + (PASS == 0 ? 0 : 1024) + col), g);
                    v0 = v0 * (f32x4){g[0], g[1], g[2], g[3]}; v1 = v1 * (f32x4){g[4], g[5], g[6], g[7]};
                    bf16_t* t = T + (size_t)row * 1024 + col;
                    if (PASS == 0) { *(u32x4*)t = pack8(v0, v1); }
                    else { float tv[8]; unpack8(*(const u32x4*)t, tv); v0 = v0 + (f32x4){tv[0], tv[1], tv[2], tv[3]}; v1 = v1 + (f32x4){tv[4], tv[5], tv[6], tv[7]}; *(u32x4*)(MG + (size_t)row * 1024 + col) = pack8(v0, v1); }
                }
            }
    }
};

struct Order4 {
    pg8::StaticOrder S0; int G, c; const unsigned* flag;
    __device__ __forceinline__ void init(int G_, int c_, const unsigned* f) { S0.init(SEQ, 1024, G_, c_, 1024); G = G_; c = c_; flag = f; }
    __device__ __forceinline__ bool next(int i, pg8::Unit& u) const {
        const long L = (long)i * G + c;
        if (L < 256) return S0.next(i, u);
        const int s = (int)L - 256; if (s >= 64) return false;
        const int id = s >> 2;
        u.pm = 64 + (id >> 2); u.pn = id & 3; u.k0 = 4 * (s & 3); u.nk = 4; u.sel = 0; return true;
    }
    __device__ __forceinline__ void a_ready(const pg8::Unit& u) const { if (u.pm >= 64) wait_flag(flag, NSAMP); }
    __device__ __forceinline__ void done(const pg8::Unit&) const {}
};
struct Order5 {
    pg8::StaticOrder S0; const unsigned* flag; const float* rss; LAS float* lr; mutable int nready;
    __device__ __forceinline__ void init(int G_, int c_, const unsigned* f, const float* rss_, LAS float* lr_) { S0.init(MROWS, 2 * DFF, G_, c_, 1024); flag = f; rss = rss_; lr = lr_; nready = 0; }
    __device__ __forceinline__ bool next(int i, pg8::Unit& u) const { return S0.next(i, u); }
    __device__ __forceinline__ void a_ready(const pg8::Unit& u) const {
        if (u.pm >= 64) wait_flag(flag, NSAMP);
        if (threadIdx.x < 256) lr[(nready & 1) * 256 + threadIdx.x] = rsqrtf(rss[u.pm * 256 + threadIdx.x] * (1.0f / 1024.0f) + EPS);
        ++nready;
    }
    __device__ __forceinline__ void done(const pg8::Unit&) const {}
};
struct Epi4 {
    static constexpr bool PERM = true, AFTER_DRAIN = false;
    const float* xp; const float* xs; float* Y; bf16_t* HN; const float* nw; float* rss; float* PB;
    __device__ __forceinline__ void operator()(AccRef acc, const pg8::Unit& u, int wr, int wc, int fr, int fq) const {
        if (u.pm >= 64) {
            float* pb = PB + (size_t)(u.k0 >> 2) * (NSAMP * 1024) - (size_t)SEQ * 1024;
#pragma unroll
            for (int ai = 0; ai < 2; ++ai)
#pragma unroll
                for (int m = 0; m < 4; ++m) {
                    const int row = u.pm * 256 + ai * 128 + wr * 64 + m * 16 + fr;
#pragma unroll
                    for (int bj = 0; bj < 2; ++bj) { float* p = pb + (size_t)row * 1024 + u.pn * 256 + bj * 128 + wc * 32 + 8 * fq; *(f32x4*)p = acc[ai][bj][m][0]; *(f32x4*)(p + 4) = acc[ai][bj][m][1]; }
                }
            return;
        }
        const float* xb = xp;
        f32x4 w[2][2];
#pragma unroll
        for (int bj = 0; bj < 2; ++bj) { const int col = u.pn * 256 + bj * 128 + wc * 32 + 8 * fq; w[bj][0] = *(const f32x4*)(nw + col); w[bj][1] = *(const f32x4*)(nw + col + 4); }
#pragma unroll
        for (int ai = 0; ai < 2; ++ai)
#pragma unroll
            for (int m = 0; m < 4; ++m) {
                const int row = u.pm * 256 + ai * 128 + wr * 64 + m * 16 + fr;
                float s = 0.f;
#pragma unroll
                for (int bj = 0; bj < 2; ++bj) {
                    const int col = u.pn * 256 + bj * 128 + wc * 32 + 8 * fq;
                    const float* xr = xb + (size_t)row * 1024 + col;
                    const f32x4 v0 = acc[ai][bj][m][0] + *(const f32x4*)xr, v1 = acc[ai][bj][m][1] + *(const f32x4*)(xr + 4);
                    float* y = Y + (size_t)row * 1024 + col; *(f32x4*)y = v0; *(f32x4*)(y + 4) = v1;
                    *(u32x4*)(HN + (size_t)row * 1024 + col) = pack8(v0 * w[bj][0], v1 * w[bj][1]);
                    s += (v0[0] * v0[0] + v0[1] * v0[1]) + (v0[2] * v0[2] + v0[3] * v0[3]) + (v1[0] * v1[0] + v1[1] * v1[1]) + (v1[2] * v1[2] + v1[3] * v1[3]);
                }
                s += __shfl_xor(s, 16); s += __shfl_xor(s, 32);
                if (fq == 0) atomicAdd(rss + row, s);
            }
    }
};

struct Epi5 {
    static constexpr bool PERM = true, AFTER_DRAIN = false;
    bf16_t* HF; const LAS float* lr; mutable int ndone;
    __device__ __forceinline__ void operator()(AccRef acc, const pg8::Unit& u, int wr, int wc, int fr, int fq) const {
        const int slot = (ndone & 1) * 256; ++ndone;
#pragma unroll
        for (int ai = 0; ai < 2; ++ai)
#pragma unroll
            for (int m = 0; m < 4; ++m) {
                const int row = u.pm * 256 + ai * 128 + wr * 64 + m * 16 + fr;
                const float rstd = lr[slot + ai * 128 + wr * 64 + m * 16 + fr];
                f32x4 h[2];
#pragma unroll
                for (int n = 0; n < 2; ++n) {
                    const f32x4 g = acc[ai][0][m][n] * rstd, up = acc[ai][1][m][n] * rstd;
#pragma unroll
                    for (int e = 0; e < 4; ++e) h[n][e] = g[e] * sigm(g[e]) * up[e];
                }
                *(u32x4*)(HF + (size_t)row * DFF + u.pn * 128 + wc * 32 + 8 * fq) = pack8(h[0], h[1]);
            }
    }
};

struct Order6 {
    pg8::StaticOrder S0; int G, c;
    __device__ __forceinline__ void init(int G_, int c_) { S0.init(SEQ, 1024, G_, c_, DFF); G = G_; c = c_; }
    __device__ __forceinline__ bool next(int i, pg8::Unit& u) const {
        const long L = (long)i * G + c;
        if (L < 256) return S0.next(i, u);
        const int s = (int)L - 256; if (s >= 176) return false;
        const int id = s / 11, ch = s - 11 * id;
        u.pm = 64 + (id >> 2); u.pn = id & 3; u.k0 = 4 * ch; u.nk = 4; u.sel = 0; return true;
    }
    __device__ __forceinline__ void a_ready(const pg8::Unit&) const {}
    __device__ __forceinline__ void done(const pg8::Unit&) const {}
};
struct Epi6 {
    static constexpr bool PERM = true, AFTER_DRAIN = false;
    float* Y; float* PART; bf16_t* X2b;
    __device__ __forceinline__ void operator()(AccRef acc, const pg8::Unit& u, int wr, int wc, int fr, int fq) const {
        const bool full = u.pm < 64;
        float* base = full ? Y : PART + (size_t)(u.k0 >> 2) * (NSAMP * 1024) - (size_t)SEQ * 1024;
#pragma unroll
        for (int ai = 0; ai < 2; ++ai)
#pragma unroll
            for (int m = 0; m < 4; ++m) {
                const int row = u.pm * 256 + ai * 128 + wr * 64 + m * 16 + fr;
#pragma unroll
                for (int bj = 0; bj < 2; ++bj) {
                    float* y = base + (size_t)row * 1024 + u.pn * 256 + bj * 128 + wc * 32 + 8 * fq;
                    f32x4 v0 = acc[ai][bj][m][0], v1 = acc[ai][bj][m][1];
                    if (full) { v0 = v0 + *(const f32x4*)y; v1 = v1 + *(const f32x4*)(y + 4); *(u32x4*)(X2b + (y - Y)) = pack8(v0, v1); }
                    else { *(f32x4*)y = v0; *(f32x4*)(y + 4) = v1; }
                }
            }
    }
};

#define MFMA32(a, b, c) __builtin_amdgcn_mfma_f32_32x32x16_bf16((a), (b), (c), 0, 0, 0)
struct AttnSt { float m, l; f32x16 o0, o1; };
__device__ __forceinline__ bf16x8 packp(const f32x16& p, int s) {
    u32x4 w; w.x = cvtpk(p[8 * s], p[8 * s + 1]); w.y = cvtpk(p[8 * s + 2], p[8 * s + 3]); w.z = cvtpk(p[8 * s + 4], p[8 * s + 5]); w.w = cvtpk(p[8 * s + 6], p[8 * s + 7]);
    return __builtin_bit_cast(bf16x8, w);
}
template <bool HALF>
__device__ __forceinline__ void attn_step(AttnSt& st, const bf16x8 (&qr)[4], const bf16x8 (&kf)[8], const bf16x8 (&vf)[8], f32x16 p0, f32x16 p1, LAS float* wsf, int ql, int hi) {
#pragma unroll
    for (int d0 = 0; d0 < 4; ++d0) { p0 = MFMA32(kf[d0], qr[d0], p0); if (!HALF) p1 = MFMA32(kf[4 + d0], qr[d0], p1); }
    float mx = p0[0];
#pragma unroll
    for (int r = 1; r < 16; ++r) mx = fmaxf(mx, p0[r]);
    if (!HALF) {
#pragma unroll
        for (int r = 0; r < 16; ++r) mx = fmaxf(mx, p1[r]);
    }
    mx = fmaxf(mx, __shfl_xor(mx, 32));
    if (__any(mx > st.m)) {
        const float mn = fmaxf(st.m, mx), al = __builtin_amdgcn_exp2f(st.m - mn);
        st.m = mn; st.l *= al;
        if (hi == 0) wsf[ql] = al;
        asm volatile("s_waitcnt lgkmcnt(0)" ::: "memory");
#pragma unroll
        for (int g = 0; g < 4; ++g) {
            const f32x4 a = *(const LAS f32x4*)(wsf + 8 * g + 4 * hi);
#pragma unroll
            for (int e = 0; e < 4; ++e) { st.o0[4 * g + e] *= a[e]; st.o1[4 * g + e] *= a[e]; }
        }
        asm volatile("s_waitcnt lgkmcnt(0)" ::: "memory");
    }
    float s = 0.f;
#pragma unroll
    for (int r = 0; r < 16; ++r) { p0[r] = __builtin_amdgcn_exp2f(p0[r] - st.m); s += p0[r]; }
    if (!HALF) {
#pragma unroll
        for (int r = 0; r < 16; ++r) { p1[r] = __builtin_amdgcn_exp2f(p1[r] - st.m); s += p1[r]; }
    }
    st.l += s;
    const bf16x8 a0 = packp(p0, 0), a1 = packp(p0, 1);
    st.o0 = MFMA32(a0, vf[0], st.o0); st.o1 = MFMA32(a0, vf[4], st.o1);
    st.o0 = MFMA32(a1, vf[1], st.o0); st.o1 = MFMA32(a1, vf[5], st.o1);
    if (!HALF) {
        const bf16x8 a2 = packp(p1, 0), a3 = packp(p1, 1);
        st.o0 = MFMA32(a2, vf[2], st.o0); st.o1 = MFMA32(a2, vf[6], st.o1);
        st.o0 = MFMA32(a3, vf[3], st.o0); st.o1 = MFMA32(a3, vf[7], st.o1);
    }
}
__device__ __forceinline__ void attn_finish(AttnSt& st, bf16_t* orow0, LAS float* wsf, int ql, int hi) {
    const float lt = st.l + __shfl_xor(st.l, 32);
    if (hi == 0) wsf[ql] = 1.0f / lt;
    asm volatile("s_waitcnt lgkmcnt(0)" ::: "memory");
#pragma unroll
    for (int g = 0; g < 4; ++g) {
        const f32x4 a = *(const LAS f32x4*)(wsf + 8 * g + 4 * hi);
#pragma unroll
        for (int e = 0; e < 4; ++e) {
            bf16_t* o = orow0 + (size_t)(8 * g + 4 * hi + e) * 512 + ql;
            o[0] = cvt1(st.o0[4 * g + e] * a[e]); o[32] = cvt1(st.o1[4 * g + e] * a[e]);
        }
    }
    asm volatile("s_waitcnt lgkmcnt(0)" ::: "memory");
}

__device__ __forceinline__ void attn_prompt_item(int q0, int h, const bf16_t* Qb, const bf16_t* Kb, const bf16_t* Vt, const float* LH2, const float* TT2,
                                                 const float* hnQ, const float* hnK, bf16_t* OA, LAS float* wsf, int lane) {
    const int ql = lane & 31, hi = lane >> 5;
    const int jd = q0 >> 6, qoff = q0 & 63;
    bf16x8 qr[4];
    { const bf16_t* qp = Qb + (size_t)(q0 + ql) * 512 + h * 64 + 8 * hi;
#pragma unroll
      for (int d0 = 0; d0 < 4; ++d0) qr[d0] = *(const bf16x8*)(qp + 16 * d0); }
    const float* lh = LH2 + (size_t)h * SEQ;
    const float cq = lh[q0 + ql];
    float nb;
    { const int t128 = q0 >> 7;
      const float qa = sqrtf(hnQ[(t128 * 8 + h) * 2]), qb = sqrtf(hnQ[(t128 * 8 + h) * 2 + 1]);
      const float kda = sqrtf(hnK[(t128 * 8 + h) * 2]), kdb = sqrtf(hnK[(t128 * 8 + h) * 2 + 1]);
      float ka = fmaxf(hnK[(lane * 8 + h) * 2], hnK[((lane + 64) * 8 + h) * 2]), kb = fmaxf(hnK[(lane * 8 + h) * 2 + 1], hnK[((lane + 64) * 8 + h) * 2 + 1]);
      ka = sqrtf(wave_max(ka)); kb = sqrtf(wave_max(kb));
      nb = 1.02f * (qa * (ka + kda) + qb * (kb + kdb)) + 2.0f; }
    const float l2q0 = __shfl(cq, 0);
    AttnSt st; st.m = -INFINITY; st.l = 0.f;
#pragma unroll
    for (int r = 0; r < 16; ++r) { st.o0[r] = 0.f; st.o1[r] = 0.f; }
    float sub = 0.f;
    for (int j = jd; j >= 0; --j) {
        const bool diag = (j == jd);
        if (!diag) {
            if (nb + l2q0 + sub < -152.f) break;
            sub += TT2[j * 8 + h];
        }
        bf16x8 kf[8], vf[8];
        const bf16_t* kb = Kb + (size_t)(64 * j + ql) * 512 + h * 64 + 8 * hi;
#pragma unroll
        for (int half = 0; half < 2; ++half)
#pragma unroll
            for (int d0 = 0; d0 < 4; ++d0) kf[half * 4 + d0] = *(const bf16x8*)(kb + (size_t)half * 32 * 512 + 16 * d0);
        const bf16_t* vb = Vt + ((size_t)(h * 256 + j) * 64 + ql) * 64 + 8 * hi;
#pragma unroll
        for (int dh = 0; dh < 2; ++dh)
#pragma unroll
            for (int ks = 0; ks < 4; ++ks) vf[dh * 4 + ks] = *(const bf16x8*)(vb + dh * 32 * 64 + 16 * ks);
        const float cqs = cq + sub;
        f32x16 p0, p1;
#pragma unroll
        for (int g = 0; g < 4; ++g) {
            const f32x4 c0 = *(const f32x4*)(lh + 64 * j + 8 * g + 4 * hi), c1 = *(const f32x4*)(lh + 64 * j + 32 + 8 * g + 4 * hi);
#pragma unroll
            for (int e = 0; e < 4; ++e) {
                float b0 = cqs - c0[e], b1 = cqs - c1[e];
                if (diag) { const int kv = 8 * g + 4 * hi + e; if (kv > qoff + ql) b0 = -INFINITY; if (kv + 32 > qoff + ql) b1 = -INFINITY; }
                p0[4 * g + e] = b0; p1[4 * g + e] = b1;
            }
        }
        attn_step<false>(st, qr, kf, vf, p0, p1, wsf, ql, hi);
    }
    attn_finish(st, OA + (size_t)q0 * 512 + h * 64, wsf, ql, hi);
}

__device__ __forceinline__ bf16x8 ldk_f32(const float* p) { const f32x4 a = *(const f32x4*)p, b = *(const f32x4*)(p + 4); return __builtin_bit_cast(bf16x8, pack8(a, b)); }
__device__ __forceinline__ bf16x8 ldv_f32(const float* p) {
    u32x4 w; w.x = cvtpk(p[0], p[512]); w.y = cvtpk(p[1024], p[1536]); w.z = cvtpk(p[8 * 512], p[9 * 512]); w.w = cvtpk(p[10 * 512], p[11 * 512]);
    return __builtin_bit_cast(bf16x8, w);
}
__device__ __forceinline__ void attn_sample_item(int b, int h, const bf16_t* Qb, const float* ck, const float* cv, const float* clf, const float* out, bf16_t* OA, LAS float* wsf, int lane) {
    const int ql = lane & 31, hi = lane >> 5;
    bf16x8 qr[4];
    { const bf16_t* qp = Qb + (size_t)(SEQ + b * 32 + ql) * 512 + h * 64 + 8 * hi;
#pragma unroll
      for (int d0 = 0; d0 < 4; ++d0) qr[d0] = *(const bf16x8*)(qp + 16 * d0); }
    float cq = out[O_LFS + (size_t)(b * 32 + ql) * 8 + h] * LOG2E;
#pragma unroll
    for (int o = 1; o < 32; o <<= 1) { const float t = __shfl_up(cq, o, 32); if (ql >= o) cq += t; }
    AttnSt st; st.m = -INFINITY; st.l = 0.f;
#pragma unroll
    for (int r = 0; r < 16; ++r) { st.o0[r] = 0.f; st.o1[r] = 0.f; }
    bf16x8 kf[8], vf[8];
    {
        if (hi == 0) wsf[ql] = cq;
        asm volatile("s_waitcnt lgkmcnt(0)" ::: "memory");
        f32x16 p0, p1;
#pragma unroll
        for (int g = 0; g < 4; ++g) {
            const f32x4 c0 = *(const LAS f32x4*)(wsf + 8 * g + 4 * hi);
#pragma unroll
            for (int e = 0; e < 4; ++e) { const int kv = 8 * g + 4 * hi + e; p0[4 * g + e] = (kv > ql) ? -INFINITY : cq - c0[e]; p1[4 * g + e] = 0.f; }
        }
        asm volatile("s_waitcnt lgkmcnt(0)" ::: "memory");
        const float* kb = out + O_KS + ((size_t)(b * 32 + ql) * 8 + h) * 64 + 8 * hi;
        const float* vb = out + O_VS + ((size_t)(b * 32 + 4 * hi) * 8 + h) * 64 + ql;
#pragma unroll
        for (int d0 = 0; d0 < 4; ++d0) kf[d0] = ldk_f32(kb + 16 * d0);
#pragma unroll
        for (int dh = 0; dh < 2; ++dh)
#pragma unroll
            for (int ks = 0; ks < 2; ++ks) vf[dh * 4 + ks] = ldv_f32(vb + dh * 32 + (size_t)ks * 16 * 512);
        attn_step<true>(st, qr, kf, vf, p0, p1, wsf, ql, hi);
    }
    float carry = 0.f;
    for (int j = PAST / 64 - 1; j >= 0; --j) {
        const float lfc = clf[((size_t)b * PAST + 64 * j + lane) * 8 + h] * LOG2E;
        float inc = lfc;
#pragma unroll
        for (int o = 1; o < 64; o <<= 1) { const float t = __shfl_down(inc, o); if (lane + o < 64) inc += t; }
        wsf[64 + lane] = inc - lfc + carry;
        carry += __shfl(inc, 0);
        asm volatile("s_waitcnt lgkmcnt(0)" ::: "memory");
#pragma unroll 1
        for (int half = 1; half >= 0; --half) {
            f32x16 p0, p1;
#pragma unroll
            for (int g = 0; g < 4; ++g) {
                const f32x4 c0 = *(const LAS f32x4*)(wsf + 64 + 32 * half + 8 * g + 4 * hi);
#pragma unroll
                for (int e = 0; e < 4; ++e) { p0[4 * g + e] = cq + c0[e]; p1[4 * g + e] = 0.f; }
            }
            const float* kb = ck + (((size_t)b * PAST + 64 * j + 32 * half + ql) * 8 + h) * 64 + 8 * hi;
            const float* vb = cv + (((size_t)b * PAST + 64 * j + 32 * half + 4 * hi) * 8 + h) * 64 + ql;
#pragma unroll
            for (int d0 = 0; d0 < 4; ++d0) kf[d0] = ldk_f32(kb + 16 * d0);
#pragma unroll
            for (int dh = 0; dh < 2; ++dh)
#pragma unroll
                for (int ks = 0; ks < 2; ++ks) vf[dh * 4 + ks] = ldv_f32(vb + dh * 32 + (size_t)ks * 16 * 512);
            attn_step<true>(st, qr, kf, vf, p0, p1, wsf, ql, hi);
        }
    }
    attn_finish(st, OA + (size_t)(SEQ + b * 32) * 512 + h * 64, wsf, ql, hi);
}


constexpr int AT_SLOT = 17408, AT_V = 8192, AT_X = 16384;
#define AT_WAITV(n) asm volatile("s_waitcnt vmcnt(" #n ") lgkmcnt(0)" ::: "memory")
__device__ __forceinline__ void attn_prompt_block(int qb, int h, const bf16_t* Qb, const bf16_t* Kb, const bf16_t* Vt, const u32x4* KX, const float* LH2, const float* TT2,
                                                  const float* hnQ, const float* hnK, bf16_t* OA, LAS unsigned char* lds, LAS float* wsf, LAS float* offs, int wave, int lane) {
    const int ql = lane & 31, hi = lane >> 5, wh = wave >> 1;
    const int q0 = 256 * qb + 32 * wave, qoff = (32 * wave) & 63;
    bf16x8 qr[4];
    { const bf16_t* qp = Qb + (size_t)(q0 + ql) * 512 + h * 64 + 8 * hi;
#pragma unroll
      for (int d0 = 0; d0 < 4; ++d0) qr[d0] = *(const bf16x8*)(qp + 16 * d0); }
    const float* lh = LH2 + (size_t)h * SEQ;
    const float cq = lh[q0 + ql];
    float nbL;
    { const int ta = 2 * qb, tb2 = 2 * qb + 1;
      const float qa = sqrtf(fmaxf(hnQ[(ta * 8 + h) * 2], hnQ[(tb2 * 8 + h) * 2])), qbn = sqrtf(fmaxf(hnQ[(ta * 8 + h) * 2 + 1], hnQ[(tb2 * 8 + h) * 2 + 1]));
      const float kda = sqrtf(fmaxf(hnK[(ta * 8 + h) * 2], hnK[(tb2 * 8 + h) * 2])), kdb = sqrtf(fmaxf(hnK[(ta * 8 + h) * 2 + 1], hnK[(tb2 * 8 + h) * 2 + 1]));
      float ka = fmaxf(hnK[(lane * 8 + h) * 2], hnK[((lane + 64) * 8 + h) * 2]), kb = fmaxf(hnK[(lane * 8 + h) * 2 + 1], hnK[((lane + 64) * 8 + h) * 2 + 1]);
      ka = sqrtf(wave_max(ka)); kb = sqrtf(wave_max(kb));
      nbL = 1.02f * (qa * (ka + kda) + qbn * (kb + kdb)) + 2.0f + lh[256 * qb]; }
    const float tb0 = TT2[(4 * qb) * 8 + h], tb1 = TT2[(4 * qb + 1) * 8 + h], tb2v = TT2[(4 * qb + 2) * 8 + h];
    const float pre1 = tb0, pre2 = tb0 + tb1, pre3 = pre2 + tb2v;
    const float prew = (wh == 0) ? 0.f : (wh == 1) ? pre1 : (wh == 2) ? pre2 : pre3;
    int count = 4 * qb;
    { float carry = 0.f;
      for (int base = 0; base < 4 * qb; base += 64) {
          const int i = base + lane, j = 4 * qb - 1 - i;
          const float tt = (j >= 0) ? TT2[j * 8 + h] : 0.f;
          float inc = tt;
#pragma unroll
          for (int o = 1; o < 64; o <<= 1) { const float t = __shfl_up(inc, o); if (lane >= o) inc += t; }
          const float sexcl = inc - tt + carry;
          const bool cond = (j < 0) || (nbL + sexcl < -152.f);
          if (j >= 0) offs[i] = inc + carry;
          const unsigned long long bal = __ballot(cond);
          if (bal) { count = base + (int)__ffsll((long long)bal) - 1; break; }
          carry += __shfl(inc, 63);
      } }
    const int NT = 4 + count, jmax = 4 * qb + 3;
    const int r8 = 8 * wave + (lane >> 3), cc = (lane & 7) ^ ((r8 >> 1) & 7);
    const bf16_t* ksrc = Kb + (size_t)r8 * 512 + h * 64 + 8 * cc;
    const bf16_t* vsrc = Vt + ((size_t)(h * 256) * 64 + r8) * 64 + 8 * cc;
    const u32x4* xsrc = KX + (size_t)h * SEQ + lane;
    const int swz = (ql >> 1) & 7;
    int fo[4];
#pragma unroll
    for (int d0 = 0; d0 < 4; ++d0) fo[d0] = ql * 128 + 16 * ((2 * d0 + hi) ^ swz);
#define AT_DMA(tt_) do { const int j_ = jmax - (tt_); LAS unsigned char* sl_ = lds + ((tt_) % 3) * AT_SLOT; \
        __builtin_amdgcn_global_load_lds((const unsigned*)(ksrc + (size_t)j_ * 64 * 512), (LAS unsigned*)(sl_ + wave * 1024), 16, 0, 0); \
        __builtin_amdgcn_global_load_lds((const unsigned*)(vsrc + (size_t)j_ * 4096), (LAS unsigned*)(sl_ + AT_V + wave * 1024), 16, 0, 0); \
        if (wave == 0) __builtin_amdgcn_global_load_lds((const unsigned*)(xsrc + (size_t)j_ * 64), (LAS unsigned*)(sl_ + AT_X), 16, 0, 0); } while (0)
    AT_DMA(0); AT_DMA(1);
    AttnSt st; st.m = -INFINITY; st.l = 0.f;
#pragma unroll
    for (int r = 0; r < 16; ++r) { st.o0[r] = 0.f; st.o1[r] = 0.f; }
    bf16x8 qx;
#pragma unroll
    for (int e = 0; e < 8; ++e) qx[e] = (hi == 0 && e < 2) ? (short)0xBF80 : (short)0;
    const bf16x8 zero8 = (bf16x8){0, 0, 0, 0, 0, 0, 0, 0};
    const int jd = 4 * qb + wh;
    for (int t = 0; t < NT; ++t) {
        if (t + 1 < NT) { if (wave == 0) AT_WAITV(3); else AT_WAITV(2); } else AT_WAITV(0);
        __builtin_amdgcn_s_barrier();
        if (t + 2 < NT) AT_DMA(t + 2);
        const int j = jmax - t;
        if (j > jd) continue;
        float off;
        if (t < 4) { const int kk = 3 - t; const float prek = (kk == 0) ? 0.f : (kk == 1) ? pre1 : (kk == 2) ? pre2 : pre3; off = prew - prek; }
        else off = prew + offs[t - 4];
        const float cqs = cq + off;
        const LAS unsigned char* sl = lds + (t % 3) * AT_SLOT;
        f32x16 p0, p1;
        if (j == jd) {
#pragma unroll
            for (int r = 0; r < 16; ++r) { const int kv = crow(r, hi); p0[r] = (kv > qoff + ql) ? -INFINITY : cqs; p1[r] = (kv + 32 > qoff + ql) ? -INFINITY : cqs; }
        } else {
#pragma unroll
            for (int r = 0; r < 16; ++r) { p0[r] = cqs; p1[r] = cqs; }
        }
        { bf16x8 x0 = *(const LAS bf16x8*)(sl + AT_X + 16 * ql), x1 = *(const LAS bf16x8*)(sl + AT_X + 16 * (ql + 32));
          if (hi) { x0 = zero8; x1 = zero8; }
          p0 = MFMA32(x0, qx, p0); p1 = MFMA32(x1, qx, p1); }
        bf16x8 kf[8], vf[8];
#pragma unroll
        for (int half = 0; half < 2; ++half)
#pragma unroll
            for (int d0 = 0; d0 < 4; ++d0) { kf[half * 4 + d0] = *(const LAS bf16x8*)(sl + half * 4096 + fo[d0]); vf[half * 4 + d0] = *(const LAS bf16x8*)(sl + AT_V + half * 4096 + fo[d0]); }
        attn_step<false>(st, qr, kf, vf, p0, p1, wsf, ql, hi);
    }
#undef AT_DMA
    attn_finish(st, OA + (size_t)q0 * 512 + h * 64, wsf, ql, hi);
}

__device__ __forceinline__ void attn_sample_block(int b, int h, const bf16_t* Qb, const float* ck, const float* cv, const float* clf, const float* out, bf16_t* OA,
                                                  LAS unsigned char* lds, LAS float* wsf, int wave, int lane, int tid) {
    const int ql = lane & 31, hi = lane >> 5;
    bf16x8 qr[4];
    { const bf16_t* qp = Qb + (size_t)(SEQ + b * 32 + ql) * 512 + h * 64 + 8 * hi;
#pragma unroll
      for (int d0 = 0; d0 < 4; ++d0) qr[d0] = *(const bf16x8*)(qp + 16 * d0); }
    float cq = out[O_LFS + (size_t)(b * 32 + ql) * 8 + h] * LOG2E;
#pragma unroll
    for (int o = 1; o < 32; o <<= 1) { const float t = __shfl_up(cq, o, 32); if (ql >= o) cq += t; }
    LAS float* segt = (LAS float*)(lds + 68608);
    const int s0 = 128 * wave;
    const float lf0 = clf[((size_t)b * PAST + s0 + 2 * lane) * 8 + h] * LOG2E, lf1 = clf[((size_t)b * PAST + s0 + 2 * lane + 1) * 8 + h] * LOG2E;
    float inc = lf0 + lf1;
#pragma unroll
    for (int o = 1; o < 64; o <<= 1) { const float t = __shfl_down(inc, o); if (lane + o < 64) inc += t; }
    if (lane == 0) segt[wave] = inc;
    __syncthreads();
    float carry = 0.f;
#pragma unroll
    for (int w2 = 1; w2 < 8; ++w2) if (w2 > wave) carry += segt[w2];
    { const float s1 = inc - lf0 - lf1 + carry; *(LAS f32x2*)(wsf + 128 + 2 * lane) = (f32x2){s1 + lf1, s1}; }
    asm volatile("s_waitcnt lgkmcnt(0)" ::: "memory");
    AttnSt st; st.m = -INFINITY; st.l = 0.f;
#pragma unroll
    for (int r = 0; r < 16; ++r) { st.o0[r] = 0.f; st.o1[r] = 0.f; }
    bf16x8 kf[8], vf[8];
#pragma unroll 1
    for (int ht = 3; ht >= 0; --ht) {
        f32x16 p0, p1;
#pragma unroll
        for (int g = 0; g < 4; ++g) {
            const f32x4 c0 = *(const LAS f32x4*)(wsf + 128 + 32 * ht + 8 * g + 4 * hi);
#pragma unroll
            for (int e = 0; e < 4; ++e) { p0[4 * g + e] = cq + c0[e]; p1[4 * g + e] = 0.f; }
        }
        const float* kb = ck + (((size_t)b * PAST + s0 + 32 * ht + ql) * 8 + h) * 64 + 8 * hi;
        const float* vb = cv + (((size_t)b * PAST + s0 + 32 * ht + 4 * hi) * 8 + h) * 64 + ql;
#pragma unroll
        for (int d0 = 0; d0 < 4; ++d0) kf[d0] = ldk_f32(kb + 16 * d0);
#pragma unroll
        for (int dh = 0; dh < 2; ++dh)
#pragma unroll
            for (int ks = 0; ks < 2; ++ks) vf[dh * 4 + ks] = ldv_f32(vb + dh * 32 + (size_t)ks * 16 * 512);
        attn_step<true>(st, qr, kf, vf, p0, p1, wsf, ql, hi);
    }
    if (wave == 7) {
        if (hi == 0) wsf[ql] = cq;
        asm volatile("s_waitcnt lgkmcnt(0)" ::: "memory");
        f32x16 p0, p1;
#pragma unroll
        for (int g = 0; g < 4; ++g) {
            const f32x4 c0 = *(const LAS f32x4*)(wsf + 8 * g + 4 * hi);
#pragma unroll
            for (int e = 0; e < 4; ++e) { const int kv = 8 * g + 4 * hi + e; p0[4 * g + e] = (kv > ql) ? -INFINITY : cq - c0[e]; p1[4 * g + e] = 0.f; }
        }
        asm volatile("s_waitcnt lgkmcnt(0)" ::: "memory");
        const float* kb = out + O_KS + ((size_t)(b * 32 + ql) * 8 + h) * 64 + 8 * hi;
        const float* vb = out + O_VS + ((size_t)(b * 32 + 4 * hi) * 8 + h) * 64 + ql;
#pragma unroll
        for (int d0 = 0; d0 < 4; ++d0) kf[d0] = ldk_f32(kb + 16 * d0);
#pragma unroll
        for (int dh = 0; dh < 2; ++dh)
#pragma unroll
            for (int ks = 0; ks < 2; ++ks) vf[dh * 4 + ks] = ldv_f32(vb + dh * 32 + (size_t)ks * 16 * 512);
        attn_step<true>(st, qr, kf, vf, p0, p1, wsf, ql, hi);
    }
    LAS float* po = (LAS float*)(lds + wave * 8448);
    const float lt = st.l + __shfl_xor(st.l, 32);
#pragma unroll
    for (int r = 0; r < 16; ++r) { po[crow(r, hi) * 64 + ql] = st.o0[r]; po[crow(r, hi) * 64 + 32 + ql] = st.o1[r]; }
    if (hi == 0) { po[2048 + ql] = st.m; po[2080 + ql] = lt; }
    __syncthreads();
    { const int q = tid >> 4, d4 = (tid & 15) * 4;
      float mw[8], M = -INFINITY;
#pragma unroll
      for (int w2 = 0; w2 < 8; ++w2) { mw[w2] = ((const LAS float*)(lds + w2 * 8448))[2048 + q]; M = fmaxf(M, mw[w2]); }
      float L = 0.f; f32x4 O = (f32x4){0.f, 0.f, 0.f, 0.f};
#pragma unroll
      for (int w2 = 0; w2 < 8; ++w2) { const LAS float* pw = (const LAS float*)(lds + w2 * 8448); const float wg = __builtin_amdgcn_exp2f(mw[w2] - M);
          L += wg * pw[2080 + q]; O = O + *(const LAS f32x4*)(pw + q * 64 + d4) * wg; }
      const float inv = 1.0f / L;
      u32x2 w; w.x = cvtpk(O[0] * inv, O[1] * inv); w.y = cvtpk(O[2] * inv, O[3] * inv);
      *(u32x2*)(OA + (size_t)(SEQ + b * 32 + q) * 512 + h * 64 + d4) = w; }
    __syncthreads();
}

constexpr int PL_STRIDE = 136;
template <int W>
__device__ __forceinline__ void pool_fill(int rt, int g, const float* P, const float* state_pool, LAS bf16_t* At, int tid) {
    const int cq = tid & 31, rg = tid >> 5;
    const int row0 = rt * 128 + 8 * rg, col = g * 128 + 4 * cq;
    const bool prompt = rt < 128;
    const float* pb; const float* hb; int nh;
    if (prompt) { pb = P + (size_t)row0 * 512 + col; hb = nullptr; nh = row0; }
    else { const int rs = row0 - SEQ, b = rs >> 5, tl0 = rs & 31; pb = P + (size_t)row0 * 512 + col; hb = state_pool + (size_t)(b * 15 + 15 + tl0) * 512 + col; nh = tl0; }
    auto ld = [&](int rr) -> f32x4 {
        if (rr + nh >= 0) return *(const f32x4*)(pb + (ptrdiff_t)rr * 512);
        if (hb) return *(const f32x4*)(hb + (ptrdiff_t)rr * 512);
        return (f32x4){0.f, 0.f, 0.f, 0.f};
    };
    f32x4 s = ld(-(W - 1));
#pragma unroll
    for (int i = 1; i < W - 1; ++i) s = s + ld(i - (W - 1));
    f32x4 cur = ld(0);
    s = s + cur;
#pragma unroll
    for (int i = 0; i < 8; ++i) {
        if (i > 0) { cur = ld(i); s = s + (cur - ld(i - W)); }
        float cnt = (float)W;
        if (prompt) { const int t = row0 + i; cnt = (float)((t + 1 < W) ? (t + 1) : W); }
        const f32x4 d = s * __builtin_amdgcn_rcpf(cnt) - cur;
        u32x2 w; w.x = cvtpk(d[0], d[1]); w.y = cvtpk(d[2], d[3]);
        *(LAS u32x2*)(At + (8 * rg + i) * PL_STRIDE + 4 * cq) = w;
    }
}
__device__ __forceinline__ void pool_item(int rt, int g, const float* P, const float* state_pool, const bf16_t* Wpg, const float* pool_scale, bf16_t* OP, LAS unsigned char* lds, int tid) {
    LAS bf16_t* At = (LAS bf16_t*)lds; LAS bf16_t* Bt = At + 128 * PL_STRIDE;
    if (g == 0) pool_fill<2>(rt, g, P, state_pool, At, tid);
    else if (g == 1) pool_fill<4>(rt, g, P, state_pool, At, tid);
    else if (g == 2) pool_fill<8>(rt, g, P, state_pool, At, tid);
    else pool_fill<16>(rt, g, P, state_pool, At, tid);
#pragma unroll
    for (int i = 0; i < 4; ++i) { const int idx = tid + 512 * i, n = idx >> 4, kc = (idx & 15) * 8;
        *(LAS u32x4*)(Bt + n * PL_STRIDE + kc) = *(const u32x4*)(Wpg + (size_t)g * 16384 + n * 128 + kc); }
    __syncthreads();
    const int wid = tid >> 6, lane = tid & 63, ql = lane & 31, hi = lane >> 5;
    const int r0 = 32 * (wid & 3), c0 = 64 * (wid >> 2);
    f32x16 a0, a1;
#pragma unroll
    for (int r = 0; r < 16; ++r) { a0[r] = 0.f; a1[r] = 0.f; }
#pragma unroll
    for (int ks = 0; ks < 8; ++ks) {
        const bf16x8 af = *(const LAS bf16x8*)(At + (r0 + ql) * PL_STRIDE + 16 * ks + 8 * hi);
        const bf16x8 b0 = *(const LAS bf16x8*)(Bt + (c0 + ql) * PL_STRIDE + 16 * ks + 8 * hi);
        const bf16x8 b1 = *(const LAS bf16x8*)(Bt + (c0 + 32 + ql) * PL_STRIDE + 16 * ks + 8 * hi);
        a0 = MFMA32(af, b0, a0); a1 = MFMA32(af, b1, a1);
    }
    const float s0 = pool_scale[g * 128 + c0 + ql], s1 = pool_scale[g * 128 + c0 + 32 + ql];
#pragma unroll
    for (int r = 0; r < 16; ++r) {
        bf16_t* o = OP + (size_t)(rt * 128 + r0 + crow(r, hi)) * 512 + g * 128 + c0 + ql;
        o[0] = cvt1(a0[r] * s0); o[32] = cvt1(a1[r] * s1);
    }
    __syncthreads();
}

__device__ __forceinline__ void tr_item(const float* W, int ldw, int Kdim, bf16_t* WT, int drow0, int k0, int n0src, LAS float* scr, int lane) {
#pragma unroll 8
    for (int i = 0; i < 32; ++i) { const int kk = 2 * i + (lane >> 5); scr[kk * 33 + (lane & 31)] = W[(size_t)(k0 + kk) * ldw + n0src + (lane & 31)]; }
    asm volatile("s_waitcnt lgkmcnt(0)" ::: "memory");
    const int c = lane & 7;
#pragma unroll
    for (int j = 0; j < 4; ++j) { const int n = (lane >> 3) + 8 * j; const LAS float* s = scr + (8 * c) * 33 + n;
        u32x4 o; o.x = cvtpk(s[0 * 33], s[1 * 33]); o.y = cvtpk(s[2 * 33], s[3 * 33]); o.z = cvtpk(s[4 * 33], s[5 * 33]); o.w = cvtpk(s[6 * 33], s[7 * 33]);
        *(u32x4*)(WT + (size_t)(drow0 + n) * Kdim + k0 + 8 * c) = o; }
    asm volatile("s_waitcnt lgkmcnt(0)" ::: "memory");
}

#define XB_TMO      128
#define XB_XCNT(j)  (256  + 64 * (j))
#define XB_XSUB(j)  (1280 + 64 * (j))
#define XB_XGEN(j)  (2304 + 64 * (j))
#define XB_TOP      3328
#define XB_TOPGEN   3392
#define XCD_BAR_WORDS 3456
#define XB_SPIN_CAP (1u << 22)
#define BAR_MAGIC 0x5EEDBA55u
__device__ __forceinline__ unsigned xb_ld(unsigned* p)              { return __hip_atomic_load(p, __ATOMIC_RELAXED, __HIP_MEMORY_SCOPE_AGENT); }
__device__ __forceinline__ unsigned xb_add(unsigned* p, unsigned v) { return __hip_atomic_fetch_add(p, v, __ATOMIC_RELAXED, __HIP_MEMORY_SCOPE_AGENT); }
__device__ __forceinline__ unsigned xb_xcc_id() { return (unsigned)__builtin_amdgcn_s_getreg((3 << 11) | 20) & 0xFu; }
#define XB_SPIN(cond, bar) do { unsigned _sp = 0; while (cond) { __builtin_amdgcn_s_sleep(1); \
    if ((++_sp & 255u) == 0u) { if (xb_ld(&(bar)[XB_TMO])) break; if (_sp > XB_SPIN_CAP) { atomicAdd(&(bar)[XB_TMO], 1u); break; } } } } while (0)
struct XcdBarrier { unsigned* bar; unsigned x; volatile LAS unsigned* st; };
__device__ __forceinline__ XcdBarrier xcd_barrier_post(unsigned* bar, volatile LAS unsigned* st) {
    XcdBarrier b; b.bar = bar; b.x = xb_xcc_id(); b.st = st;
    if (threadIdx.x == 0) (void)xb_add(&bar[XB_XCNT(b.x)], 1u);
    return b;
}
__device__ __forceinline__ void xcd_barrier_complete(unsigned* bar, unsigned x, unsigned& nloc, unsigned& nx) {
    const unsigned G = gridDim.x * gridDim.y * gridDim.z;
    unsigned sum, cnt, mine, sp = 0u;
    for (;;) {
        sum = 0u; cnt = 0u; mine = 0u;
#pragma unroll
        for (unsigned j = 0; j < 16; ++j) { const unsigned c = xb_ld(&bar[XB_XCNT(j)]); sum += c; cnt += (c > 0u) ? 1u : 0u; mine = (j == x) ? c : mine; }
        if (sum == G) break;
        __builtin_amdgcn_s_sleep(1);
        if ((++sp & 255u) == 0u) { if (xb_ld(&bar[XB_TMO])) break; if (sp > XB_SPIN_CAP) { atomicAdd(&bar[XB_TMO], 1u); break; } }
    }
    nloc = mine > 0u ? mine : 1u; nx = cnt > 0u ? cnt : 1u;
}
__device__ __forceinline__ void xcd_barrier(const XcdBarrier& b) {
    asm volatile("s_waitcnt vmcnt(0)" ::: "memory");
    __syncthreads();
    if (threadIdx.x == 0) {
        unsigned* bar = b.bar;
        __builtin_amdgcn_s_waitcnt(0);
        unsigned nloc = b.st[0], nx = b.st[1];
        if (nloc == 0u) { xcd_barrier_complete(bar, b.x, nloc, nx); b.st[0] = nloc; b.st[1] = nx; }
        const unsigned old = xb_add(&bar[XB_XSUB(b.x)], 1u);
        const unsigned gen = old / nloc;
        if (old + 1u == (gen + 1u) * nloc) {
            __builtin_amdgcn_fence(__ATOMIC_RELEASE, "agent");
            asm volatile("s_waitcnt vmcnt(0)" ::: "memory");
            const unsigned og = xb_add(&bar[XB_TOP], 1u);
            const unsigned tg = og / nx;
            if (og + 1u == (tg + 1u) * nx) xb_add(&bar[XB_TOPGEN], 1u);
            else XB_SPIN(xb_ld(&bar[XB_TOPGEN]) == tg, bar);
            __builtin_amdgcn_fence(__ATOMIC_ACQUIRE, "agent");
            xb_add(&bar[XB_XGEN(b.x)], 1u);
            asm volatile("s_waitcnt vmcnt(0)" ::: "memory");
        } else {
            XB_SPIN(xb_ld(&bar[XB_XGEN(b.x)]) == gen, bar);
            __builtin_amdgcn_fence(__ATOMIC_ACQUIRE, "agent");
            asm volatile("s_waitcnt vmcnt(0)" ::: "memory");
        }
    }
    __syncthreads();
}

struct Params {
    const float* in[20];
    float* out;
    unsigned char* ws;
    int ph_lo, ph_hi;
};

constexpr int LDS_BYTES = 147456;
constexpr int NTHREADS = 512;

__global__ void __launch_bounds__(NTHREADS, 2) fwd_kernel(Params p) {
    extern __shared__ __attribute__((aligned(16))) unsigned char lds_raw[];
    LAS unsigned char* lds = (LAS unsigned char*)lds_raw;
    const int tid = threadIdx.x, lane = tid & 63, wave = __builtin_amdgcn_readfirstlane(tid >> 6);
    const int G = gridDim.x, bx = blockIdx.x;
    unsigned* barw = (unsigned*)(p.ws + WS_BAR);
    volatile LAS unsigned* bst = (volatile LAS unsigned*)(lds + LDS_BYTES - 64);
    XcdBarrier xbar; xbar.bar = barw; xbar.x = 0; xbar.st = bst;
    if (p.ph_lo == -12345) cg::this_grid().sync();
    unsigned* startw = (unsigned*)(p.ws + WS_BAR + 16384);
    if (p.ph_hi - p.ph_lo > 1) {
        if (tid < 2) bst[tid] = 0u;
        if (bx == 0) {
            for (int i = tid; i < XCD_BAR_WORDS; i += NTHREADS) barw[i] = 0u;
            asm volatile("s_waitcnt vmcnt(0)" ::: "memory"); __syncthreads();
            if (tid == 0) { __builtin_amdgcn_fence(__ATOMIC_RELEASE, "agent"); asm volatile("s_waitcnt vmcnt(0)" ::: "memory"); __hip_atomic_store(startw, BAR_MAGIC, __ATOMIC_RELAXED, __HIP_MEMORY_SCOPE_AGENT); }
        } else if (tid == 0) {
            while (__hip_atomic_load(startw, __ATOMIC_RELAXED, __HIP_MEMORY_SCOPE_AGENT) != BAR_MAGIC) __builtin_amdgcn_s_sleep(2);
            __builtin_amdgcn_fence(__ATOMIC_ACQUIRE, "agent");
        }
        __syncthreads();
        xbar = xcd_barrier_post(barw, bst);
    }
    const int gw = bx * 8 + wave, NGW = G * 8;
    unsigned char* ws = p.ws; float* out = p.out;
    const float* x_prompt = p.in[0]; const float* x_sample = p.in[1]; const float* cache_k = p.in[2]; const float* cache_v = p.in[3];
    const float* cache_logf = p.in[4]; const float* state_pool = p.in[5]; const float* norm_mix = p.in[6]; const float* w_in = p.in[7];
    const float* b_forget = p.in[8]; const float* w_pool_group = p.in[9]; const float* pool_scale = p.in[10]; const float* w_branch_pool = p.in[11];
    const float* w_branch_attn = p.in[12]; const float* b_gate = p.in[13]; const float* w_out = p.in[14]; const float* norm_ffn = p.in[15];
    const float* w_ffn_gate = p.in[16]; const float* w_ffn_up = p.in[17]; const float* w_ffn_down = p.in[18]; const float* norm_final = p.in[19];
    float* hnQ = (float*)(ws + WS_CTL + CTL_HNQ); float* hnK = (float*)(ws + WS_CTL + CTL_HNK);
    float* rss1 = (float*)(ws + WS_CTL + CTL_RSS1); float* rss2 = (float*)(ws + WS_CTL + CTL_RSS2);
    unsigned* ctr = (unsigned*)(ws + WS_CTL + CTL_CTR); unsigned* flag3 = ctr + 16; unsigned* flag4 = ctr + 32;
    bf16_t* X2b = (bf16_t*)(ws + WS_OP);
    float* PA = (float*)(ws + WS_Q); float* PB = (float*)(ws + WS_OP);
    float* TT2 = (float*)(ws + WS_TT); float* LH2 = (float*)(ws + WS_LH); u32x4* KX = (u32x4*)(ws + WS_KX);
    bf16_t* W1t = (bf16_t*)(ws + WS_W1); bf16_t* Wbp = (bf16_t*)(ws + WS_WBP); bf16_t* Wba = (bf16_t*)(ws + WS_WBA); bf16_t* Wo = (bf16_t*)(ws + WS_WO);
    bf16_t* Wgu = (bf16_t*)(ws + WS_WGU); bf16_t* Wd = (bf16_t*)(ws + WS_WD); bf16_t* Wpg = (bf16_t*)(ws + WS_WPG);
    bf16_t* XN = (bf16_t*)(ws + WS_XN); bf16_t* MG = (bf16_t*)(ws + WS_XN); bf16_t* Gt = (bf16_t*)(ws + WS_G); bf16_t* HN = (bf16_t*)(ws + WS_G);
    float* PART = (float*)(ws + WS_XN);
    float* Pf = (float*)(ws + WS_P); bf16_t* Qb = (bf16_t*)(ws + WS_Q); bf16_t* Kb = (bf16_t*)(ws + WS_K); bf16_t* Vt = (bf16_t*)(ws + WS_V);
    bf16_t* OP = (bf16_t*)(ws + WS_OP); bf16_t* OA = (bf16_t*)(ws + WS_OA); bf16_t* Tf = (bf16_t*)(ws + WS_T); bf16_t* HF = (bf16_t*)(ws + WS_HF);
    const int lo = p.ph_lo, hi_ph = p.ph_hi;
#define IN(k) (lo <= (k) && (k) < hi_ph)
#define SEAM(k) do { if (IN(k) && IN((k) + 1)) xcd_barrier(xbar); } while (0)

    if (IN(0)) {
        for (size_t i = (size_t)bx * NTHREADS + tid; i < CTL_ZERO_END / 4; i += (size_t)G * NTHREADS) ((unsigned*)(ws + WS_CTL))[i] = 0u;
        LAS float* wf = (LAS float*)(lds + 73728);
        for (int i = tid; i < 8192; i += NTHREADS) wf[i] = w_in[(size_t)(i >> 3) * DIN + 2048 + (i & 7)];
        LAS float* scr = (LAS float*)(lds + wave * 8704);
        constexpr int I1 = 16 * 128, I8 = 32;
        for (int it = gw; it < I1 + I8; it += NGW) {
            int r = it;
            if (r < I1) { const int kb = r / 128, nb = r % 128, n0 = 32 * nb; tr_item(w_in, DIN, 1024, W1t, n0, 64 * kb, n0 < 2048 ? n0 : n0 + 8, scr, lane); continue; } r -= I1;
            { const int g = r >> 3, kb = (r >> 2) & 1, nb = r & 3; tr_item(w_pool_group + (size_t)g * 16384, 128, 128, Wpg + (size_t)g * 16384, 32 * nb, 64 * kb, 32 * nb, scr, lane); }
        }
        __syncthreads();
        f32x4 wfa[4][4], wfb[4][4];
#pragma unroll
        for (int j = 0; j < 4; ++j)
#pragma unroll
            for (int e = 0; e < 4; ++e) { const LAS float* wp = wf + (4 * lane + 256 * j + e) * 8; wfa[j][e] = *(const LAS f32x4*)wp; wfb[j][e] = *(const LAS f32x4*)(wp + 4); }
        f32x4 nv[4];
        if (gw < MROWS) { const float* xr = (gw < SEQ) ? x_prompt + (size_t)gw * DM : x_sample + (size_t)(gw - SEQ) * DM;
#pragma unroll
            for (int j = 0; j < 4; ++j) nv[j] = *(const f32x4*)(xr + 4 * lane + 256 * j); }
        for (int m = gw; m < MROWS; m += NGW) {
            f32x4 v[4]; float ss = 0.f;
#pragma unroll
            for (int j = 0; j < 4; ++j) { v[j] = nv[j]; ss += (v[j][0] * v[j][0] + v[j][1] * v[j][1]) + (v[j][2] * v[j][2] + v[j][3] * v[j][3]); }
            { const int m2 = m + NGW;
              if (m2 < MROWS) { const float* xr = (m2 < SEQ) ? x_prompt + (size_t)m2 * DM : x_sample + (size_t)(m2 - SEQ) * DM;
#pragma unroll
                  for (int j = 0; j < 4; ++j) nv[j] = *(const f32x4*)(xr + 4 * lane + 256 * j); } }
            const float rstd = rsqrtf(wave_sum(ss) * (1.0f / DM) + EPS);
            float fl[8];
#pragma unroll
            for (int hh = 0; hh < 8; ++hh) fl[hh] = 0.f;
#pragma unroll
            for (int j = 0; j < 4; ++j) {
                const f32x4 gm = *(const f32x4*)(norm_mix + 4 * lane + 256 * j);
                v[j] = v[j] * rstd * gm;
                u32x2 w; w.x = cvtpk(v[j][0], v[j][1]); w.y = cvtpk(v[j][2], v[j][3]);
                *(u32x2*)(XN + (size_t)m * DM + 4 * lane + 256 * j) = w;
#pragma unroll
                for (int e = 0; e < 4; ++e) {
                    const f32x4 wa = wfa[j][e], wb = wfb[j][e];
                    fl[0] += v[j][e] * wa[0]; fl[1] += v[j][e] * wa[1]; fl[2] += v[j][e] * wa[2]; fl[3] += v[j][e] * wa[3];
                    fl[4] += v[j][e] * wb[0]; fl[5] += v[j][e] * wb[1]; fl[6] += v[j][e] * wb[2]; fl[7] += v[j][e] * wb[3];
                }
            }
            float mine = 0.f;
#pragma unroll
            for (int hh = 0; hh < 8; ++hh) { const float t = wave_sum(fl[hh]); if (lane == hh) mine = t; }
            if (lane < 8) {
                const float z = mine + b_forget[lane];
                const float lf = fminf(z, 0.f) - log1pf(expf(-fabsf(z)));
                if (m < SEQ) out[O_LFP + (size_t)m * 8 + lane] = lf; else out[O_LFS + (size_t)(m - SEQ) * 8 + lane] = lf;
            }
        }
        __syncthreads();
    }
    SEAM(0);

    if (IN(1)) {
        pg8::Gemm g{XN, W1t, MROWS, 4096, 1024, nullptr, nullptr}; pg8::StaticOrder S; S.init(MROWS, 4096, G, bx, 1024);
        Epi1 E{Pf, Qb, Kb, Vt, Gt, b_gate, out, (unsigned*)hnQ, (unsigned*)hnK};
        pg8::gemm_phase<Epi1, pg8::StaticOrder, true, true>(lds, g, S, E);
        {
            const int rem = 1088 % G; const bool helper = (rem == 0) || (bx >= rem);
            if (helper) {
                const int nh = (rem == 0) ? G : G - rem, hidx = (rem == 0) ? bx : bx - rem;
                for (int tile = hidx; tile < 256; tile += nh) {
                    float inc = out[O_LFP + (size_t)(64 * tile + lane) * 8 + wave] * LOG2E;
        #pragma unroll
                    for (int o = 1; o < 64; o <<= 1) { const float t = __shfl_up(inc, o); if (lane >= o) inc += t; }
                    LH2[(size_t)wave * SEQ + 64 * tile + lane] = inc;
                    { const unsigned hb = cvtpk(inc, 0.f) & 0xffffu; const float hf = __uint_as_float(hb << 16); const unsigned lb = cvtpk(inc - hf, 0.f) & 0xffffu;
                      KX[(size_t)wave * SEQ + 64 * tile + lane] = (u32x4){hb | (lb << 16), 0u, 0u, 0u}; }
                    if (lane == 63) TT2[tile * 8 + wave] = inc;
                }
                LAS float* scr = (LAS float*)(lds + wave * 8704);
                constexpr int I2 = 8 * 32, I3 = 8 * 32, I4 = 16 * 32, I5 = 16 * 88, I6 = 16 * 88, I7 = 44 * 32;
                for (int it = hidx * 8 + wave; it < I2 + I3 + I4 + I5 + I6 + I7; it += nh * 8) {
                    int r = it;
                    if (r < I2) { const int kb = r / 32, nb = r % 32; tr_item(w_branch_pool, 1024, 512, Wbp, 32 * nb, 64 * kb, 32 * nb, scr, lane); continue; } r -= I2;
                    if (r < I3) { const int kb = r / 32, nb = r % 32; tr_item(w_branch_attn, 1024, 512, Wba, 32 * nb, 64 * kb, 32 * nb, scr, lane); continue; } r -= I3;
                    if (r < I4) { const int kb = r / 32, nb = r % 32; tr_item(w_out, 1024, 1024, Wo, 32 * nb, 64 * kb, 32 * nb, scr, lane); continue; } r -= I4;
                    if (r < I5) { const int kb = r / 88, nb = r % 88, n0 = 32 * nb; tr_item(w_ffn_gate, DFF, 1024, Wgu, 256 * (n0 >> 7) + (n0 & 127), 64 * kb, n0, scr, lane); continue; } r -= I5;
                    if (r < I6) { const int kb = r / 88, nb = r % 88, n0 = 32 * nb; tr_item(w_ffn_up, DFF, 1024, Wgu, 256 * (n0 >> 7) + 128 + (n0 & 127), 64 * kb, n0, scr, lane); continue; } r -= I6;
                    { const int kb = r / 32, nb = r % 32; tr_item(w_ffn_down, 1024, DFF, Wd, 32 * nb, 64 * kb, 32 * nb, scr, lane); }
                }
            }
        }
    }
    SEAM(1);

    if (IN(2)) {
        LAS float* wsf = (LAS float*)(lds + 69632) + wave * 256;
        LAS unsigned* sitem = (LAS unsigned*)(lds + 69632 + 8 * 1024);
        for (int i3 = bx; i3 < 544; i3 += G) pool_item(i3 >> 2, i3 & 3, Pf, state_pool, Wpg, pool_scale, OP, lds, tid);
        LAS float* offs = (LAS float*)(lds + 80000);
        for (;;) {
            if (tid == 0) sitem[0] = atomicAdd(ctr, 1u);
            __syncthreads();
            const int item = (int)sitem[0];
            __syncthreads();
            if (item >= 768) break;
            const int tri = item / 3, rm = item - 3 * tri;
            if (rm == 0) attn_sample_block(tri >> 3, tri & 7, Qb, cache_k, cache_v, cache_logf, out, OA, lds, wsf, wave, lane, tid);
            else { const int i2 = 2 * tri + rm - 1, h = i2 & 7, qb256 = 63 - (i2 >> 3);
                   attn_prompt_block(qb256, h, Qb, Kb, Vt, KX, LH2, TT2, hnQ, hnK, OA, lds, wsf, offs, wave, lane); }
        }
    }
    SEAM(2);

    if (IN(3)) {
        { pg8::Gemm g{OP, Wbp, MROWS, 1024, 512, OA, Wba}; Order3a S; S.init(G, bx); Epi3<0> E{Tf, Gt, MG, PA}; pg8::gemm_phase<Epi3<0>, Order3a, true, true>(lds, g, S, E); }
        { pg8::Gemm g{OA, Wba, SEQ, 1024, 512, nullptr, nullptr}; pg8::StaticOrder S; S.init(SEQ, 1024, G, bx, 512); Epi3<1> E{Tf, Gt, MG, PA}; pg8::gemm_phase<Epi3<1>, pg8::StaticOrder, true, true>(lds, g, S, E); }
    }
    SEAM(3);

    if (IN(4)) {
        const int hb = G - 1 - bx, nhb = (G < NSAMP / 8) ? G : NSAMP / 8;
        if (hb < nhb) for (int r = hb * 8 + wave; r < NSAMP; r += nhb * 8) {
            const bf16_t* grow = Gt + (size_t)(SEQ + r) * 2048;
#pragma unroll
            for (int j = 0; j < 4; ++j) {
                const int c = 4 * lane + 256 * j;
                const f32x4 a = *(const f32x4*)(PA + (size_t)r * 1024 + c) + *(const f32x4*)(PA + (size_t)(NSAMP + r) * 1024 + c);
                const f32x4 bq = *(const f32x4*)(PA + (size_t)(2 * NSAMP + r) * 1024 + c) + *(const f32x4*)(PA + (size_t)(3 * NSAMP + r) * 1024 + c);
                const u32x2 ga = *(const u32x2*)(grow + c), gb = *(const u32x2*)(grow + 1024 + c);
                const float m0 = a[0] * __uint_as_float(ga.x << 16) + bq[0] * __uint_as_float(gb.x << 16), m1 = a[1] * __uint_as_float(ga.x & 0xffff0000u) + bq[1] * __uint_as_float(gb.x & 0xffff0000u);
                const float m2 = a[2] * __uint_as_float(ga.y << 16) + bq[2] * __uint_as_float(gb.y << 16), m3 = a[3] * __uint_as_float(ga.y & 0xffff0000u) + bq[3] * __uint_as_float(gb.y & 0xffff0000u);
                u32x2 w; w.x = cvtpk(m0, m1); w.y = cvtpk(m2, m3);
                st_wt64(MG + (size_t)(SEQ + r) * 1024 + c, w.x, w.y);
            }
        }
        if (hb < nhb) {
            asm volatile("s_waitcnt vmcnt(0)" ::: "memory"); __syncthreads();
            if (tid == 0) __hip_atomic_fetch_add(flag3, 8u * (unsigned)((NSAMP / 8 - hb + nhb - 1) / nhb), __ATOMIC_RELAXED, __HIP_MEMORY_SCOPE_AGENT);
        }
        pg8::Gemm g{MG, Wo, MROWS, 1024, 1024, nullptr, nullptr}; Order4 S; S.init(G, bx, flag3);
        Epi4 E{x_prompt, x_sample, out + O_Y, HN, norm_ffn, rss1, PB};
        pg8::gemm_phase<Epi4, Order4, true, true>(lds, g, S, E);
    }
    SEAM(4);

    if (IN(5)) {
        const int rem5 = 1496 % G; const bool fin = (rem5 == 0) || (bx >= rem5);
        const int nh5 = (rem5 == 0) ? G : G - rem5, hidx5 = (rem5 == 0) ? bx : bx - rem5;
        if (fin) for (int r = hidx5 * 8 + wave; r < NSAMP; r += nh5 * 8) {
            float ss = 0.f;
#pragma unroll
            for (int j = 0; j < 4; ++j) {
                const int c = 4 * lane + 256 * j;
                f32x4 v = *(const f32x4*)(x_sample + (size_t)r * 1024 + c);
#pragma unroll
                for (int ch = 0; ch < 4; ++ch) v = v + *(const f32x4*)(PB + (size_t)(ch * NSAMP + r) * 1024 + c);
                *(f32x4*)(out + O_Y + (size_t)(SEQ + r) * 1024 + c) = v;
                const f32x4 nw = *(const f32x4*)(norm_ffn + c);
                u32x2 w; w.x = cvtpk(v[0] * nw[0], v[1] * nw[1]); w.y = cvtpk(v[2] * nw[2], v[3] * nw[3]);
                st_wt64(HN + (size_t)(SEQ + r) * 1024 + c, w.x, w.y);
                ss += (v[0] * v[0] + v[1] * v[1]) + (v[2] * v[2] + v[3] * v[3]);
            }
            ss = wave_sum(ss);
            if (lane == 0) __hip_atomic_store((unsigned*)(rss1 + SEQ + r), __float_as_uint(ss), __ATOMIC_RELAXED, __HIP_MEMORY_SCOPE_AGENT);
        }
        if (fin && hidx5 < NSAMP / 8) {
            asm volatile("s_waitcnt vmcnt(0)" ::: "memory"); __syncthreads();
            if (tid == 0) __hip_atomic_fetch_add(flag4, 8u * (unsigned)((NSAMP / 8 - hidx5 + nh5 - 1) / nh5), __ATOMIC_RELAXED, __HIP_MEMORY_SCOPE_AGENT);
        }
        pg8::Gemm g{HN, Wgu, MROWS, 2 * DFF, 1024, nullptr, nullptr}; LAS float* lrs = (LAS float*)(lds + 131072 + 1024); Order5 S; S.init(G, bx, flag4, rss1, lrs);
        Epi5 E{HF, lrs, 0};
        pg8::gemm_phase<Epi5, Order5, true, true>(lds, g, S, E);
    }
    SEAM(5);

    if (IN(6)) {
        pg8::Gemm g{HF, Wd, MROWS, 1024, DFF, nullptr, nullptr}; Order6 S; S.init(G, bx);
        Epi6 E{out + O_Y, PART, X2b};
        pg8::gemm_phase<Epi6, Order6, true, true>(lds, g, S, E);
    }
    SEAM(6);

    if (IN(7)) {
        for (int m = gw; m < MROWS; m += NGW) {
            float* y = out + O_Y + (size_t)m * DM;
            f32x4 v[4]; float ss = 0.f;
            if (m < SEQ) {
#pragma unroll
                for (int j = 0; j < 4; ++j) { const u32x2 w = *(const u32x2*)(X2b + (size_t)m * DM + 4 * lane + 256 * j);
                    v[j] = (f32x4){__uint_as_float(w.x << 16), __uint_as_float(w.x & 0xffff0000u), __uint_as_float(w.y << 16), __uint_as_float(w.y & 0xffff0000u)}; }
            } else {
#pragma unroll
                for (int j = 0; j < 4; ++j) v[j] = *(const f32x4*)(y + 4 * lane + 256 * j);
            }
            if (m >= SEQ) {
                for (int ch = 0; ch < 11; ++ch) {
                    const float* pp = PART + (size_t)ch * (NSAMP * 1024) + (size_t)(m - SEQ) * 1024;
#pragma unroll
                    for (int j = 0; j < 4; ++j) v[j] = v[j] + *(const f32x4*)(pp + 4 * lane + 256 * j);
                }
            }
#pragma unroll
            for (int j = 0; j < 4; ++j) ss += (v[j][0] * v[j][0] + v[j][1] * v[j][1]) + (v[j][2] * v[j][2] + v[j][3] * v[j][3]);
            const float rstd = rsqrtf(wave_sum(ss) * (1.0f / DM) + EPS);
#pragma unroll
            for (int j = 0; j < 4; ++j) {
                const f32x4 gm = *(const f32x4*)(norm_final + 4 * lane + 256 * j);
                __builtin_nontemporal_store(v[j] * rstd * gm, (f32x4*)(y + 4 * lane + 256 * j));
            }
        }
    }
    if (p.ph_hi - p.ph_lo > 1 && bx == 0 && tid == 0) __hip_atomic_store(startw, 0u, __ATOMIC_RELAXED, __HIP_MEMORY_SCOPE_AGENT);
#undef IN
#undef SEAM
}

#ifndef N_LAUNCHES
#define N_LAUNCHES 1
#endif

extern "C" void kernel_launch(void* const* d_in, const int* in_sizes, int n_in, void* d_out, int out_size, void* d_ws, size_t ws_size, hipStream_t stream) {
    static int grid = 0;
    if (grid == 0) {
        int dev = 0, cus = 0, per_cu = 0;
        hipGetDevice(&dev);
        hipDeviceGetAttribute(&cus, hipDeviceAttributeMultiprocessorCount, dev);
        hipFuncSetAttribute((const void*)fwd_kernel, hipFuncAttributeMaxDynamicSharedMemorySize, LDS_BYTES);
        hipOccupancyMaxActiveBlocksPerMultiprocessor(&per_cu, (const void*)fwd_kernel, NTHREADS, LDS_BYTES);
        if (per_cu < 1) per_cu = 1;
        grid = cus * per_cu;
        (void)hipGetLastError();
    }
    Params p{};
    for (int i = 0; i < 20; ++i) p.in[i] = (const float*)d_in[i];
    p.out = (float*)d_out; p.ws = (unsigned char*)d_ws;
#if N_LAUNCHES == 1
    p.ph_lo = 0; p.ph_hi = 8;
    void* args[] = {&p};
    hipError_t e = hipLaunchCooperativeKernel((const void*)fwd_kernel, dim3(grid), dim3(NTHREADS), args, LDS_BYTES, stream);
    if (e != hipSuccess) fprintf(stderr, "cooperative launch failed: %s (grid %d)\n", hipGetErrorString(e), grid);
#else
    for (int k = 0; k < 8; ++k) {
        p.ph_lo = k; p.ph_hi = k + 1;
        hipLaunchKernelGGL(fwd_kernel, dim3(grid), dim3(NTHREADS), LDS_BYTES, stream, p);
    }
#endif
}
```

```cpp
#include <hip/hip_runtime.h>
#include <hip/hip_cooperative_groups.h>
#include <cstdio>
#include <cstdint>
namespace cg = cooperative_groups;

#define LAS __attribute__((address_space(3)))
typedef unsigned short bf16_t;
typedef short bf16x8 __attribute__((ext_vector_type(8)));
typedef float f32x4 __attribute__((ext_vector_type(4)));
typedef float f32x2 __attribute__((ext_vector_type(2)));
typedef float f32x16 __attribute__((ext_vector_type(16)));
typedef unsigned u32x4 __attribute__((ext_vector_type(4)));
typedef unsigned u32x2 __attribute__((ext_vector_type(2)));
typedef __bf16 bf16x2_t __attribute__((ext_vector_type(2)));

constexpr int DM = 1024, SEQ = 16384, NSAMP = 1024, MROWS = SEQ + NSAMP;
constexpr int PAST = 1024, NH = 8, DIN = 4104, DFF = 2816;
constexpr float EPS = 1e-6f, LOG2E = 1.4426950408889634f, C2 = 0.125f * 1.4426950408889634f;
constexpr size_t O_Y = 0, O_KP = 17825792, O_VP = 26214400, O_LFP = 34603008, O_POOLP = 34734080, O_KS = 34741760, O_VS = 35266048,
                 O_LFS = 35790336, O_POOLS = 35798528;
constexpr size_t MiB = 1u << 20;
constexpr size_t WS_CTL = 0;
constexpr size_t CTL_HNQ = 0, CTL_HNK = 16384, CTL_RSS1 = 32768, CTL_RSS2 = 32768 + 81920, CTL_CTR = 32768 + 2 * 81920, CTL_ZERO_END = CTL_CTR + 256;
constexpr size_t WS_BAR = 208 * 1024;
constexpr size_t WS_TT = 256 * 1024;
constexpr size_t WS_LH = 384 * 1024;
constexpr size_t WS_W1 = 1 * MiB;
constexpr size_t WS_WBP = 9 * MiB, WS_WBA = 10 * MiB, WS_WO = 11 * MiB;
constexpr size_t WS_WGU = 13 * MiB;
constexpr size_t WS_WD = 24 * MiB;
constexpr size_t WS_WPG = 30 * MiB;
constexpr size_t WS_XN = 32 * MiB;
constexpr size_t WS_G = 66 * MiB;
constexpr size_t WS_P = 134 * MiB;
constexpr size_t WS_Q = 168 * MiB, WS_K = 185 * MiB, WS_V = 201 * MiB;
constexpr size_t WS_OP = 217 * MiB, WS_OA = 234 * MiB;
constexpr size_t WS_T = 134 * MiB;
constexpr size_t WS_KX = 251 * MiB;
constexpr size_t WS_HF = 100 * MiB;

__device__ __forceinline__ unsigned cvtpk(float lo, float hi) { f32x2 v = {lo, hi}; bf16x2_t b = __builtin_convertvector(v, bf16x2_t); return __builtin_bit_cast(unsigned, b); }
__device__ __forceinline__ unsigned short cvt1(float x) { return (unsigned short)(cvtpk(x, 0.f) & 0xffffu); }
__device__ __forceinline__ float bf2f(unsigned short b) { return __uint_as_float(((unsigned)b) << 16); }
__device__ __forceinline__ int crow(int r, int hi) { return (r & 3) + 8 * (r >> 2) + 4 * hi; }
__device__ __forceinline__ float wave_sum(float v) {
#pragma unroll
    for (int o = 1; o < 64; o <<= 1) v += __shfl_xor(v, o);
    return v;
}
__device__ __forceinline__ float wave_max(float v) {
#pragma unroll
    for (int o = 1; o < 64; o <<= 1) v = fmaxf(v, __shfl_xor(v, o));
    return v;
}

namespace pg8 {
constexpr int BM = 256, BK = 64, HALF = 128, HTB = HALF * BK * 2, STAGE_BYTES = 8 * HTB, NXCD = 8, WGM = 8;
__host__ __device__ __forceinline__ int lds_byte(int r, int c) { const int st = (r >> 4) * 2 + (c >> 5), rr = r & 15, cc = c & 31, ob = rr * 64 + cc * 2; return st * 1024 + (ob ^ (((ob >> 9) & 1) << 5)); }
__host__ __device__ __forceinline__ void stage_rc(int b, int& R, int& C) { const int st = b / 1024, sb = b % 1024, swz = sb ^ (((sb >> 9) & 1) << 5); R = (st >> 1) * 16 + swz / 64; C = (st & 1) * 32 + (swz % 64) / 2; }
__host__ __device__ __forceinline__ int perm32(int rho) { const int n = rho >> 4, i = rho & 15; return 8 * (i >> 2) + 4 * n + (i & 3); }
struct Unit { int pm, pn, k0, nk, sel; };
struct Gemm { const bf16_t* A; const bf16_t* Bt; int M, N, K; const bf16_t* A2; const bf16_t* B2; };
struct StaticOrder {
    int nM, nN, nwg, G, c, nkf;
    __host__ __device__ __forceinline__ void init(int M, int N, int G_, int c_, int K_) { nM = M / BM; nN = N / BM; nwg = nM * nN; G = G_; c = c_; nkf = K_ / BK; }
    __host__ __device__ __forceinline__ bool next(int i, Unit& u) const {
        const long L = (long)i * G + c; if (L >= nwg) return false;
        int wgid = (int)L; { const int q = nwg / NXCD, r = nwg % NXCD, xcd = wgid % NXCD, off = wgid / NXCD; wgid = (xcd < r ? xcd * (q + 1) : r * (q + 1) + (xcd - r) * q) + off; }
        const int nig = WGM * nN, gid = wgid / nig, fm = gid * WGM, gsz = (nM - fm) < WGM ? (nM - fm) : WGM;
        u.pm = fm + ((wgid % nig) % gsz); u.pn = (wgid % nig) / gsz; u.k0 = 0; u.nk = nkf; u.sel = 0; return true;
    }
    __device__ __forceinline__ void a_ready(const Unit&) const {}
    __device__ __forceinline__ void done(const Unit&) const {}
};

template <class Epi, class Sched, bool ALIGN_EPI = false, bool SP2 = false>
__device__ __forceinline__ void gemm_phase(LAS unsigned char* lds, const Gemm g, const Sched& S, const Epi& E) {
    const int tid = threadIdx.x, wid = __builtin_amdgcn_readfirstlane(tid >> 6), lane = tid & 63, wr = wid >> 2, wc = wid & 3, fr = lane & 15, fq = lane >> 4;
    const int K = g.K;
    unsigned voffA[2], voffB[2];
#pragma unroll
    for (int i = 0; i < 2; ++i) { int R, C; stage_rc(tid * 16 + i * 8192, R, C); const int Rb = Epi::PERM ? ((R & ~31) + perm32(R & 31)) : R;
        voffA[i] = (unsigned)(R * K + C) * 2u; voffB[i] = (unsigned)(Rb * K + C) * 2u; }
    const size_t kstep = (size_t)(BK * 2);
    const size_t hstep = (size_t)HALF * K * 2;
    const size_t tstep = 2 * hstep;
    const unsigned ldsw = (unsigned)wid * 1024u;
    const int aoff = lds_byte(wr * 64 + fr, fq * 8), boff = lds_byte(wc * 32 + fr, fq * 8);
#define PG8_SA(b, h) (((b) * 2 + (h)) * HTB)
#define PG8_SB(b, h) ((4 + (b) * 2 + (h)) * HTB)
#define PG8_STAGE(bufoff, gbase, voff) do { _Pragma("unroll") for (int _i = 0; _i < 2; ++_i) \
        __builtin_amdgcn_global_load_lds((const unsigned*)((const char*)(gbase) + (voff)[_i]), (LAS unsigned*)(lds + (bufoff) + ldsw + _i * 8192), 16, 0, 0); } while (0)
#define PG8_LDA(dst, b, h) do { _Pragma("unroll") for (int m = 0; m < 4; ++m) _Pragma("unroll") for (int k = 0; k < 2; ++k) dst[m][k] = *(const LAS bf16x8*)(lds + PG8_SA(b, h) + aoff + m * 2048 + k * 1024); } while (0)
#define PG8_LDB(dst, b, h) do { _Pragma("unroll") for (int n = 0; n < 2; ++n) _Pragma("unroll") for (int k = 0; k < 2; ++k) dst[n][k] = *(const LAS bf16x8*)(lds + PG8_SB(b, h) + boff + n * 2048 + k * 1024); } while (0)
#define PG8_MMA(ai, bj, At, Bt) do { __builtin_amdgcn_s_setprio(1); _Pragma("unroll") for (int m = 0; m < 4; ++m) _Pragma("unroll") for (int n = 0; n < 2; ++n) _Pragma("unroll") for (int k = 0; k < 2; ++k) \
        acc[ai][bj][m][n] = __builtin_amdgcn_mfma_f32_16x16x32_bf16(Bt[n][k], At[m][k], acc[ai][bj][m][n], 0, 0, 0); __builtin_amdgcn_s_setprio(0); } while (0)
#define PG8_WAIT_V(n) asm volatile("s_waitcnt vmcnt(" #n ")" ::: "memory")
#define PG8_WAIT_L(n) asm volatile("s_waitcnt lgkmcnt(" #n ")" ::: "memory")
#define PG8_BAR __builtin_amdgcn_s_barrier()
#define PG8_SCHED __builtin_amdgcn_sched_barrier(0)
    Unit cur, nxt; int ui = 0;
    if (!S.next(0, cur)) return;
    f32x4 acc[2][2][4][2];
#pragma unroll
    for (int a = 0; a < 2; ++a)
#pragma unroll
        for (int b = 0; b < 2; ++b)
#pragma unroll
            for (int m = 0; m < 4; ++m)
#pragma unroll
                for (int n = 0; n < 2; ++n) acc[a][b][m][n] = (f32x4){0.f, 0.f, 0.f, 0.f};
    bf16x8 At[4][2], B0[2][2], B1[2][2];
    const char* cA = (const char*)(cur.sel ? g.A2 : g.A) + (size_t)cur.pm * tstep + (size_t)cur.k0 * kstep; const char* cB = (const char*)(cur.sel ? g.B2 : g.Bt) + (size_t)cur.pn * tstep + (size_t)cur.k0 * kstep;
    S.a_ready(cur);
    if constexpr (SP2) {
        PG8_STAGE(PG8_SB(0, 0), cB, voffB); PG8_STAGE(PG8_SB(0, 1), cB + hstep, voffB); PG8_STAGE(PG8_SA(0, 0), cA, voffA); PG8_STAGE(PG8_SA(0, 1), cA + hstep, voffA);
        if (wr == 1) PG8_BAR;
        PG8_WAIT_V(2); PG8_BAR;
        PG8_STAGE(PG8_SB(1, 0), cB + kstep, voffB); PG8_STAGE(PG8_SA(1, 0), cA + kstep, voffA); PG8_STAGE(PG8_SB(1, 1), cB + hstep + kstep, voffB);
        PG8_WAIT_V(6); PG8_BAR;
    } else {
        PG8_STAGE(PG8_SB(0, 0), cB, voffB); PG8_STAGE(PG8_SA(0, 0), cA, voffA); PG8_STAGE(PG8_SB(0, 1), cB + hstep, voffB); PG8_STAGE(PG8_SA(0, 1), cA + hstep, voffA);
        if (wr == 1) PG8_BAR;
        PG8_WAIT_V(4); PG8_BAR;
        PG8_STAGE(PG8_SB(1, 0), cB + kstep, voffB); PG8_STAGE(PG8_SA(1, 0), cA + kstep, voffA); PG8_STAGE(PG8_SB(1, 1), cB + hstep + kstep, voffB);
        PG8_WAIT_V(6); PG8_BAR;
    }
    for (;;) {
        const bool has_next = S.next(ui + 1, nxt);
        const char* nA = has_next ? (const char*)(nxt.sel ? g.A2 : g.A) + (size_t)nxt.pm * tstep + (size_t)nxt.k0 * kstep : cA; const char* nB = has_next ? (const char*)(nxt.sel ? g.B2 : g.Bt) + (size_t)nxt.pn * tstep + (size_t)nxt.k0 * kstep : cB;
        const int nt = cur.nk;
        for (int t = 0; t < nt; t += 2) {
            const bool last = (t == nt - 2);
            const char* a1 = cA + (size_t)(t + 1) * kstep;
            const char* a2 = last ? nA : cA + (size_t)(t + 2) * kstep; const char* b2 = last ? nB : cB + (size_t)(t + 2) * kstep;
            const char* a3 = a2 + kstep; const char* b3 = b2 + kstep;
            if (last && has_next) S.a_ready(nxt);
            if constexpr (SP2) {
            PG8_LDB(B0, 0, 0); PG8_LDB(B1, 0, 1); PG8_SCHED; PG8_LDA(At, 0, 0); PG8_STAGE(PG8_SA(1, 1), a1 + hstep, voffA);
            PG8_WAIT_V(8); PG8_WAIT_L(0); PG8_BAR; PG8_MMA(0, 0, At, B0); PG8_MMA(0, 1, At, B1); PG8_BAR; PG8_SCHED;
            PG8_LDA(At, 0, 1); PG8_STAGE(PG8_SB(0, 0), b2, voffB); PG8_STAGE(PG8_SB(0, 1), b2 + hstep, voffB); PG8_STAGE(PG8_SA(0, 0), a2, voffA);
            PG8_WAIT_V(8); PG8_WAIT_L(0); PG8_BAR; PG8_MMA(1, 0, At, B0); PG8_MMA(1, 1, At, B1); PG8_BAR; PG8_SCHED;
            PG8_LDB(B0, 1, 0); PG8_LDB(B1, 1, 1); PG8_SCHED; PG8_LDA(At, 1, 0); PG8_STAGE(PG8_SA(0, 1), a2 + hstep, voffA);
            PG8_WAIT_V(8); PG8_WAIT_L(0); PG8_BAR; PG8_MMA(0, 0, At, B0); PG8_MMA(0, 1, At, B1); PG8_BAR; PG8_SCHED;
            PG8_LDA(At, 1, 1); PG8_STAGE(PG8_SB(1, 0), b3, voffB); PG8_STAGE(PG8_SB(1, 1), b3 + hstep, voffB); PG8_STAGE(PG8_SA(1, 0), a3, voffA);
            PG8_WAIT_V(8); PG8_WAIT_L(0); PG8_BAR; PG8_MMA(1, 0, At, B0); PG8_MMA(1, 1, At, B1); PG8_BAR; PG8_SCHED;
            } else {
            PG8_LDB(B0, 0, 0); PG8_SCHED; PG8_LDA(At, 0, 0); PG8_STAGE(PG8_SA(1, 1), a1 + hstep, voffA);
            PG8_WAIT_L(8); PG8_BAR; PG8_WAIT_L(0); PG8_MMA(0, 0, At, B0); PG8_BAR; PG8_SCHED;
            PG8_LDB(B1, 0, 1); PG8_STAGE(PG8_SB(0, 0), b2, voffB);
            PG8_BAR; PG8_WAIT_L(0); PG8_MMA(0, 1, At, B1); PG8_BAR;
            PG8_LDA(At, 0, 1); PG8_STAGE(PG8_SA(0, 0), a2, voffA);
            PG8_BAR; PG8_WAIT_L(0); PG8_MMA(1, 0, At, B0); PG8_BAR; PG8_SCHED;
            PG8_STAGE(PG8_SB(0, 1), b2 + hstep, voffB);
            PG8_WAIT_V(6); PG8_BAR; PG8_MMA(1, 1, At, B1); PG8_BAR;
            PG8_LDB(B0, 1, 0); PG8_SCHED; PG8_LDA(At, 1, 0); PG8_STAGE(PG8_SA(0, 1), a2 + hstep, voffA);
            PG8_WAIT_L(8); PG8_BAR; PG8_WAIT_L(0); PG8_MMA(0, 0, At, B0); PG8_BAR; PG8_SCHED;
            PG8_LDB(B1, 1, 1); PG8_STAGE(PG8_SB(1, 0), b3, voffB);
            PG8_BAR; PG8_WAIT_L(0); PG8_MMA(0, 1, At, B1); PG8_BAR;
            PG8_LDA(At, 1, 1); PG8_STAGE(PG8_SA(1, 0), a3, voffA);
            PG8_BAR; PG8_WAIT_L(0); PG8_MMA(1, 0, At, B0); PG8_BAR; PG8_SCHED;
            PG8_STAGE(PG8_SB(1, 1), b3 + hstep, voffB);
            PG8_WAIT_V(6); PG8_BAR; PG8_MMA(1, 1, At, B1); PG8_BAR;
            }
        }
        if constexpr (ALIGN_EPI) { if (wr == 0) PG8_BAR; }
        E(acc, cur, wr, wc, fr, fq); S.done(cur);
        if (!has_next) break;
#pragma unroll
        for (int a = 0; a < 2; ++a)
#pragma unroll
            for (int b = 0; b < 2; ++b)
#pragma unroll
                for (int m = 0; m < 4; ++m)
#pragma unroll
                    for (int n = 0; n < 2; ++n) acc[a][b][m][n] = (f32x4){0.f, 0.f, 0.f, 0.f};
        cur = nxt; cA = nA; cB = nB; ++ui;
        if constexpr (ALIGN_EPI) { if (wr == 1) PG8_BAR; }
    }
    PG8_WAIT_V(0);
    if constexpr (!ALIGN_EPI) { if (wr == 0) PG8_BAR; }
    PG8_BAR;
#undef PG8_SA
#undef PG8_SB
#undef PG8_STAGE
#undef PG8_LDA
#undef PG8_LDB
#undef PG8_MMA
#undef PG8_WAIT_V
#undef PG8_WAIT_L
#undef PG8_BAR
#undef PG8_SCHED
}
}

typedef const f32x4 (&AccRef)[2][2][4][2];
__device__ __forceinline__ u32x4 pack8(f32x4 a, f32x4 b) { u32x4 w; w.x = cvtpk(a[0], a[1]); w.y = cvtpk(a[2], a[3]); w.z = cvtpk(b[0], b[1]); w.w = cvtpk(b[2], b[3]); return w; }
__device__ __forceinline__ float sigm(float x) { return __builtin_amdgcn_rcpf(1.0f + __builtin_amdgcn_exp2f(-1.4426950408889634f * x)); }
__device__ __forceinline__ void unpack8(u32x4 w, float* g) {
    g[0] = __uint_as_float(w.x << 16); g[1] = __uint_as_float(w.x & 0xffff0000u); g[2] = __uint_as_float(w.y << 16); g[3] = __uint_as_float(w.y & 0xffff0000u);
    g[4] = __uint_as_float(w.z << 16); g[5] = __uint_as_float(w.z & 0xffff0000u); g[6] = __uint_as_float(w.w << 16); g[7] = __uint_as_float(w.w & 0xffff0000u);
}

struct Epi1 {
    static constexpr bool PERM = true, AFTER_DRAIN = false;
    float* P; bf16_t* Qb; bf16_t* Kb; bf16_t* Vt; bf16_t* G; const float* b_gate; float* out; unsigned* hnQ; unsigned* hnK;
    __device__ __forceinline__ void operator()(AccRef acc, const pg8::Unit& u, int wr, int wc, int fr, int fq) const {
        const int kind = u.pn; const bool prompt = u.pm < 64;
        const int cb = wc * 32 + 8 * fq;
        if (kind < 2) {
#pragma unroll
            for (int ai = 0; ai < 2; ++ai)
#pragma unroll
                for (int m = 0; m < 4; ++m) {
                    const int row = u.pm * 256 + ai * 128 + wr * 64 + m * 16 + fr;
                    float* po = nullptr;
                    if (prompt) { if (row >= SEQ - 15) po = out + O_POOLP + (size_t)(row - (SEQ - 15)) * 512; }
                    else { const int rs = row - SEQ, t = rs & 31; if (t >= 17) po = out + O_POOLS + (size_t)((rs >> 5) * 15 + t - 17) * 512; }
#pragma unroll
                    for (int bj = 0; bj < 2; ++bj) {
                        const int lc = kind * 256 + bj * 128 + cb;
                        float* dst = P + (size_t)row * 512 + lc;
                        *(f32x4*)dst = acc[ai][bj][m][0]; *(f32x4*)(dst + 4) = acc[ai][bj][m][1];
                        if (po) { *(f32x4*)(po + lc) = acc[ai][bj][m][0]; *(f32x4*)(po + lc + 4) = acc[ai][bj][m][1]; }
                    }
                }
        } else if (kind < 6) {
            const bool isq = kind < 4;
            const int base = isq ? 512 : 1024;
            const float sc = isq ? C2 : 1.0f;
            float* fo = prompt ? out + O_KP : out + O_KS - (size_t)SEQ * 512;
#pragma unroll
            for (int ai = 0; ai < 2; ++ai)
#pragma unroll
                for (int bj = 0; bj < 2; ++bj) {
                    const int lc = kind * 256 - base + bj * 128 + cb;
                    float mx = 0.f;
#pragma unroll
                    for (int m = 0; m < 4; ++m) {
                        const int row = u.pm * 256 + ai * 128 + wr * 64 + m * 16 + fr;
                        const f32x4 v0 = acc[ai][bj][m][0] * sc, v1 = acc[ai][bj][m][1] * sc;
                        if (isq) { *(u32x4*)(Qb + (size_t)row * 512 + lc) = pack8(v0, v1); }
                        else {
                            float* d = fo + (size_t)row * 512 + lc; __builtin_nontemporal_store(v0, (f32x4*)d); __builtin_nontemporal_store(v1, (f32x4*)(d + 4));
                            if (prompt) *(u32x4*)(Kb + (size_t)row * 512 + lc) = pack8(v0, v1);
                        }
                        float s = (v0[0] * v0[0] + v0[1] * v0[1]) + (v0[2] * v0[2] + v0[3] * v0[3]) + (v1[0] * v1[0] + v1[1] * v1[1]) + (v1[2] * v1[2] + v1[3] * v1[3]);
                        s += __shfl_xor(s, 16); s += __shfl_xor(s, 32);
                        mx = fmaxf(mx, s);
                    }
                    if (prompt) {
                        mx = fmaxf(mx, __shfl_xor(mx, 1)); mx = fmaxf(mx, __shfl_xor(mx, 2)); mx = fmaxf(mx, __shfl_xor(mx, 4)); mx = fmaxf(mx, __shfl_xor(mx, 8));
                        const int colbase = kind * 256 - base + bj * 128 + wc * 32;
                        if (fr == 0 && fq == 0) atomicMax((isq ? hnQ : hnK) + ((2 * u.pm + ai) * 8 + (colbase >> 6)) * 2 + ((colbase >> 5) & 1), __float_as_uint(mx));
                    }
                }
        } else if (kind < 8) {
            float* fo = prompt ? out + O_VP : out + O_VS - (size_t)SEQ * 512;
#pragma unroll
            for (int ai = 0; ai < 2; ++ai)
#pragma unroll
                for (int m = 0; m < 4; ++m) {
                    const int row = u.pm * 256 + ai * 128 + wr * 64 + m * 16 + fr;
                    const int o16 = row & 15, kvp = (row & 48) + 8 * ((o16 >> 2) & 1) + (o16 & 3) + 4 * (o16 >> 3);
#pragma unroll
                    for (int bj = 0; bj < 2; ++bj) {
                        const int lc = kind * 256 - 1536 + bj * 128 + cb;
                        const f32x4 v0 = acc[ai][bj][m][0], v1 = acc[ai][bj][m][1];
                        float* d = fo + (size_t)row * 512 + lc; __builtin_nontemporal_store(v0, (f32x4*)d); __builtin_nontemporal_store(v1, (f32x4*)(d + 4));
                        if (prompt) {
                            bf16_t* vt = Vt + ((size_t)((lc >> 6) * 256 + (row >> 6)) * 64 + (lc & 63)) * 64 + kvp;
                            vt[0] = cvt1(v0[0]); vt[64] = cvt1(v0[1]); vt[128] = cvt1(v0[2]); vt[192] = cvt1(v0[3]);
                            vt[256] = cvt1(v1[0]); vt[320] = cvt1(v1[1]); vt[384] = cvt1(v1[2]); vt[448] = cvt1(v1[3]);
                        }
                    }
                }
        } else {
#pragma unroll
            for (int bj = 0; bj < 2; ++bj) {
                const int lc = kind * 256 - 2048 + bj * 128 + cb;
                const f32x4 b0 = *(const f32x4*)(b_gate + lc), b1 = *(const f32x4*)(b_gate + lc + 4);
#pragma unroll
                for (int ai = 0; ai < 2; ++ai)
#pragma unroll
                    for (int m = 0; m < 4; ++m) {
                        const int row = u.pm * 256 + ai * 128 + wr * 64 + m * 16 + fr;
                        f32x4 v0 = acc[ai][bj][m][0] + b0, v1 = acc[ai][bj][m][1] + b1;
#pragma unroll
                        for (int e = 0; e < 4; ++e) { v0[e] = sigm(v0[e]); v1[e] = sigm(v1[e]); }
                        *(u32x4*)(G + (size_t)row * 2048 + lc) = pack8(v0, v1);
                    }
            }
        }
    }
};

__device__ __forceinline__ void st_wt64(void* p, unsigned lo, unsigned hi) {
    __hip_atomic_store((unsigned long long*)p, ((unsigned long long)hi << 32) | lo, __ATOMIC_RELAXED, __HIP_MEMORY_SCOPE_AGENT);
}
__device__ __forceinline__ void wait_flag(const unsigned* flag, unsigned want) {
    while (__hip_atomic_load(flag, __ATOMIC_RELAXED, __HIP_MEMORY_SCOPE_AGENT) < want) __builtin_amdgcn_s_sleep(2);
    asm volatile("" ::: "memory");
}
struct Order3a {
    pg8::StaticOrder S0; int G, c;
    __device__ __forceinline__ void init(int G_, int c_) { S0.init(SEQ, 1024, G_, c_, 512); G = G_; c = c_; }
    __device__ __forceinline__ bool next(int i, pg8::Unit& u) const {
        const long L = (long)i * G + c;
        if (L < 256) return S0.next(i, u);
        const int s = (int)L - 256; if (s >= 64) return false;
        const int r = s & 31, id = r >> 1;
        u.pm = 64 + (id >> 2); u.pn = id & 3; u.k0 = 4 * (r & 1); u.nk = 4; u.sel = s >> 5; return true;
    }
    __device__ __forceinline__ void a_ready(const pg8::Unit&) const {}
    __device__ __forceinline__ void done(const pg8::Unit&) const {}
};
template <int PASS> struct Epi3 {
    static constexpr bool PERM = true, AFTER_DRAIN = false;
    bf16_t* T; const bf16_t* G; bf16_t* MG; float* PA;
    __device__ __forceinline__ void operator()(AccRef acc, const pg8::Unit& u, int wr, int wc, int fr, int fq) const {
        const bool samp = (PASS == 0) && (u.pm >= 64);
        float* pa = PA + (size_t)(2 * u.sel + (u.k0 >> 2)) * (NSAMP * 1024) - (size_t)SEQ * 1024;
#pragma unroll
        for (int ai = 0; ai < 2; ++ai)
#pragma unroll
            for (int m = 0; m < 4; ++m) {
                const int row = u.pm * 256 + ai * 128 + wr * 64 + m * 16 + fr;
#pragma unroll
                for (int bj = 0; bj < 2; ++bj) {
                    const int col = u.pn * 256 + bj * 128 + wc * 32 + 8 * fq;
                    f32x4 v0 = acc[ai][bj][m][0], v1 = acc[ai][bj][m][1];
                    if (samp) { float* p = pa + (size_t)row * 1024 + col; *(f32x4*)p = v0; *(f32x4*)(p + 4) = v1; continue; }
                    float g[8]; unpack8(*(const u32x4*)(G + (size_t)row * 2048 + (PASS == 0 ? 0 : 1024) + col), g);
                    v0 = v0 * (f32x4){g[0], g[1], g[2], g[3]}; v1 = v1 * (f32x4){g[4], g[5], g[6], g[7]};
                    bf16_t* t = T + (size_t)row * 1024 + col;
                    if (PASS == 0) { *(u32x4*)t = pack8(v0, v1); }
                    else { float tv[8]; unpack8(*(const u32x4*)t, tv); v0 = v0 + (f32x4){tv[0], tv[1], tv[2], tv[3]}; v1 = v1 + (f32x4){tv[4], tv[5], tv[6], tv[7]}; *(u32x4*)(MG + (size_t)row * 1024 + col) = pack8(v0, v1); }
                }
            }
    }
};

struct Order4 {
    pg8::StaticOrder S0; int G, c; const unsigned* flag;
    __device__ __forceinline__ void init(int G_, int c_, const unsigned* f) { S0.init(SEQ, 1024, G_, c_, 1024); G = G_; c = c_; flag = f; }
    __device__ __forceinline__ bool next(int i, pg8::Unit& u) const {
        const long L = (long)i * G + c;
        if (L < 256) return S0.next(i, u);
        const int s = (int)L - 256; if (s >= 64) return false;
        const int id = s >> 2;
        u.pm = 64 + (id >> 2); u.pn = id & 3; u.k0 = 4 * (s & 3); u.nk = 4; u.sel = 0; return true;
    }
    __device__ __forceinline__ void a_ready(const pg8::Unit& u) const { if (u.pm >= 64) wait_flag(flag, NSAMP); }
    __device__ __forceinline__ void done(const pg8::Unit&) const {}
};
struct Order5 {
    pg8::StaticOrder S0; const unsigned* flag; const float* rss; LAS float* lr; mutable int nready;
    __device__ __forceinline__ void init(int G_, int c_, const unsigned* f, const float* rss_, LAS float* lr_) { S0.init(MROWS, 2 * DFF, G_, c_, 1024); flag = f; rss = rss_; lr = lr_; nready = 0; }
    __device__ __forceinline__ bool next(int i, pg8::Unit& u) const { return S0.next(i, u); }
    __device__ __forceinline__ void a_ready(const pg8::Unit& u) const {
        if (u.pm >= 64) wait_flag(flag, NSAMP);
        if (threadIdx.x < 256) lr[(nready & 1) * 256 + threadIdx.x] = rsqrtf(rss[u.pm * 256 + threadIdx.x] * (1.0f / 1024.0f) + EPS);
        ++nready;
    }
    __device__ __forceinline__ void done(const pg8::Unit&) const {}
};
struct Epi4 {
    static constexpr bool PERM = true, AFTER_DRAIN = false;
    const float* xp; const float* xs; float* Y; bf16_t* HN; const float* nw; float* rss; float* PB;
    __device__ __forceinline__ void operator()(AccRef acc, const pg8::Unit& u, int wr, int wc, int fr, int fq) const {
        if (u.pm >= 64) {
            float* pb = PB + (size_t)(u.k0 >> 2) * (NSAMP * 1024) - (size_t)SEQ * 1024;
#pragma unroll
            for (int ai = 0; ai < 2; ++ai)
#pragma unroll
                for (int m = 0; m < 4; ++m) {
                    const int row = u.pm * 256 + ai * 128 + wr * 64 + m * 16 + fr;
#pragma unroll
                    for (int bj = 0; bj < 2; ++bj) { float* p = pb + (size_t)row * 1024 + u.pn * 256 + bj * 128 + wc * 32 + 8 * fq; *(f32x4*)p = acc[ai][bj][m][0]; *(f32x4*)(p + 4) = acc[ai][bj][m][1]; }
                }
            return;
        }
        const float* xb = xp;
        f32x4 w[2][2];
#pragma unroll
        for (int bj = 0; bj < 2; ++bj) { const int col = u.pn * 256 + bj * 128 + wc * 32 + 8 * fq; w[bj][0] = *(const f32x4*)(nw + col); w[bj][1] = *(const f32x4*)(nw + col + 4); }
#pragma unroll
        for (int ai = 0; ai < 2; ++ai)
#pragma unroll
            for (int m = 0; m < 4; ++m) {
                const int row = u.pm * 256 + ai * 128 + wr * 64 + m * 16 + fr;
                float s = 0.f;
#pragma unroll
                for (int bj = 0; bj < 2; ++bj) {
                    const int col = u.pn * 256 + bj * 128 + wc * 32 + 8 * fq;
                    const float* xr = xb + (size_t)row * 1024 + col;
                    const f32x4 v0 = acc[ai][bj][m][0] + *(const f32x4*)xr, v1 = acc[ai][bj][m][1] + *(const f32x4*)(xr + 4);
                    float* y = Y + (size_t)row * 1024 + col; *(f32x4*)y = v0; *(f32x4*)(y + 4) = v1;
                    *(u32x4*)(HN + (size_t)row * 1024 + col) = pack8(v0 * w[bj][0], v1 * w[bj][1]);
                    s += (v0[0] * v0[0] + v0[1] * v0[1]) + (v0[2] * v0[2] + v0[3] * v0[3]) + (v1[0] * v1[0] + v1[1] * v1[1]) + (v1[2] * v1[2] + v1[3] * v1[3]);
                }
                s += __shfl_xor(s, 16); s += __shfl_xor(s, 32);
                if (fq == 0) atomicAdd(rss + row, s);
            }
    }
};

struct Epi5 {
    static constexpr bool PERM = true, AFTER_DRAIN = false;
    bf16_t* HF; const LAS float* lr; mutable int ndone;
    __device__ __forceinline__ void operator()(AccRef acc, const pg8::Unit& u, int wr, int wc, int fr, int fq) const {
        const int slot = (ndone & 1) * 256; ++ndone;
#pragma unroll
        for (int ai = 0; ai < 2; ++ai)
#pragma unroll
            for (int m = 0; m < 4; ++m) {
                const int row = u.pm * 256 + ai * 128 + wr * 64 + m * 16 + fr;
                const float rstd = lr[slot + ai * 128 + wr * 64 + m * 16 + fr];
                f32x4 h[2];
#pragma unroll
                for (int n = 0; n < 2; ++n) {
                    const f32x4 g = acc[ai][0][m][n] * rstd, up = acc[ai][1][m][n] * rstd;
#pragma unroll
                    for (int e = 0; e < 4; ++e) h[n][e] = g[e] * sigm(g[e]) * up[e];
                }
                *(u32x4*)(HF + (size_t)row * DFF + u.pn * 128 + wc * 32 + 8 * fq) = pack8(h[0], h[1]);
            }
    }
};

struct Order6 {
    pg8::StaticOrder S0; int G, c;
    __device__ __forceinline__ void init(int G_, int c_) { S0.init(SEQ, 1024, G_, c_, DFF); G = G_; c = c_; }
    __device__ __forceinline__ bool next(int i, pg8::Unit& u) const {
        const long L = (long)i * G + c;
        if (L < 256) return S0.next(i, u);
        const int s = (int)L - 256; if (s >= 176) return false;
        const int id = s / 11, ch = s - 11 * id;
        u.pm = 64 + (id >> 2); u.pn = id & 3; u.k0 = 4 * ch; u.nk = 4; u.sel = 0; return true;
    }
    __device__ __forceinline__ void a_ready(const pg8::Unit&) const {}
    __device__ __forceinline__ void done(const pg8::Unit&) const {}
};
struct Epi6 {
    static constexpr bool PERM = true, AFTER_DRAIN = false;
    float* Y; float* PART; bf16_t* X2b;
    __device__ __forceinline__ void operator()(AccRef acc, const pg8::Unit& u, int wr, int wc, int fr, int fq) const {
        const bool full = u.pm < 64;
        float* base = full ? Y : PART + (size_t)(u.k0 >> 2) * (NSAMP * 1024) - (size_t)SEQ * 1024;
#pragma unroll
        for (int ai = 0; ai < 2; ++ai)
#pragma unroll
            for (int m = 0; m < 4; ++m) {
                const int row = u.pm * 256 + ai * 128 + wr * 64 + m * 16 + fr;
#pragma unroll
                for (int bj = 0; bj < 2; ++bj) {
                    float* y = base + (size_t)row * 1024 + u.pn * 256 + bj * 128 + wc * 32 + 8 * fq;
                    f32x4 v0 = acc[ai][bj][m][0], v1 = acc[ai][bj][m][1];
                    if (full) { v0 = v0 + *(const f32x4*)y; v1 = v1 + *(const f32x4*)(y + 4); *(u32x4*)(X2b + (y - Y)) = pack8(v0, v1); }
                    else { *(f32x4*)y = v0; *(f32x4*)(y + 4) = v1; }
                }
            }
    }
};

#define MFMA32(a, b, c) __builtin_amdgcn_mfma_f32_32x32x16_bf16((a), (b), (c), 0, 0, 0)
struct AttnSt { float m, l; f32x16 o0, o1; };
__device__ __forceinline__ bf16x8 packp(const f32x16& p, int s) {
    u32x4 w; w.x = cvtpk(p[8 * s], p[8 * s + 1]); w.y = cvtpk(p[8 * s + 2], p[8 * s + 3]); w.z = cvtpk(p[8 * s + 4], p[8 * s + 5]); w.w = cvtpk(p[8 * s + 6], p[8 * s + 7]);
    return __builtin_bit_cast(bf16x8, w);
}
template <bool HALF>
__device__ __forceinline__ void attn_step(AttnSt& st, const bf16x8 (&qr)[4], const bf16x8 (&kf)[8], const bf16x8 (&vf)[8], f32x16 p0, f32x16 p1, LAS float* wsf, int ql, int hi) {
#pragma unroll
    for (int d0 = 0; d0 < 4; ++d0) { p0 = MFMA32(kf[d0], qr[d0], p0); if (!HALF) p1 = MFMA32(kf[4 + d0], qr[d0], p1); }
    float mx = p0[0];
#pragma unroll
    for (int r = 1; r < 16; ++r) mx = fmaxf(mx, p0[r]);
    if (!HALF) {
#pragma unroll
        for (int r = 0; r < 16; ++r) mx = fmaxf(mx, p1[r]);
    }
    mx = fmaxf(mx, __shfl_xor(mx, 32));
    if (__any(mx > st.m)) {
        const float mn = fmaxf(st.m, mx), al = __builtin_amdgcn_exp2f(st.m - mn);
        st.m = mn; st.l *= al;
        if (hi == 0) wsf[ql] = al;
        asm volatile("s_waitcnt lgkmcnt(0)" ::: "memory");
#pragma unroll
        for (int g = 0; g < 4; ++g) {
            const f32x4 a = *(const LAS f32x4*)(wsf + 8 * g + 4 * hi);
#pragma unroll
            for (int e = 0; e < 4; ++e) { st.o0[4 * g + e] *= a[e]; st.o1[4 * g + e] *= a[e]; }
        }
        asm volatile("s_waitcnt lgkmcnt(0)" ::: "memory");
    }
    float s = 0.f;
#pragma unroll
    for (int r = 0; r < 16; ++r) { p0[r] = __builtin_amdgcn_exp2f(p0[r] - st.m); s += p0[r]; }
    if (!HALF) {
#pragma unroll
        for (int r = 0; r < 16; ++r) { p1[r] = __builtin_amdgcn_exp2f(p1[r] - st.m); s += p1[r]; }
    }
    st.l += s;
    const bf16x8 a0 = packp(p0, 0), a1 = packp(p0, 1);
    st.o0 = MFMA32(a0, vf[0], st.o0); st.o1 = MFMA32(a0, vf[4], st.o1);
    st.o0 = MFMA32(a1, vf[1], st.o0); st.o1 = MFMA32(a1, vf[5], st.o1);
    if (!HALF) {
        const bf16x8 a2 = packp(p1, 0), a3 = packp(p1, 1);
        st.o0 = MFMA32(a2, vf[2], st.o0); st.o1 = MFMA32(a2, vf[6], st.o1);
        st.o0 = MFMA32(a3, vf[3], st.o0); st.o1 = MFMA32(a3, vf[7], st.o1);
    }
}
__device__ __forceinline__ void attn_finish(AttnSt& st, bf16_t* orow0, LAS float* wsf, int ql, int hi) {
    const float lt = st.l + __shfl_xor(st.l, 32);
    if (hi == 0) wsf[ql] = 1.0f / lt;
    asm volatile("s_waitcnt lgkmcnt(0)" ::: "memory");
#pragma unroll
    for (int g = 0; g < 4; ++g) {
        const f32x4 a = *(const LAS f32x4*)(wsf + 8 * g + 4 * hi);
#pragma unroll
        for (int e = 0; e < 4; ++e) {
            bf16_t* o = orow0 + (size_t)(8 * g + 4 * hi + e) * 512 + ql;
            o[0] = cvt1(st.o0[4 * g + e] * a[e]); o[32] = cvt1(st.o1[4 * g + e] * a[e]);
        }
    }
    asm volatile("s_waitcnt lgkmcnt(0)" ::: "memory");
}

__device__ __forceinline__ void attn_prompt_item(int q0, int h, const bf16_t* Qb, const bf16_t* Kb, const bf16_t* Vt, const float* LH2, const float* TT2,
                                                 const float* hnQ, const float* hnK, bf16_t* OA, LAS float* wsf, int lane) {
    const int ql = lane & 31, hi = lane >> 5;
    const int jd = q0 >> 6, qoff = q0 & 63;
    bf16x8 qr[4];
    { const bf16_t* qp = Qb + (size_t)(q0 + ql) * 512 + h * 64 + 8 * hi;
#pragma unroll
      for (int d0 = 0; d0 < 4; ++d0) qr[d0] = *(const bf16x8*)(qp + 16 * d0); }
    const float* lh = LH2 + (size_t)h * SEQ;
    const float cq = lh[q0 + ql];
    float nb;
    { const int t128 = q0 >> 7;
      const float qa = sqrtf(hnQ[(t128 * 8 + h) * 2]), qb = sqrtf(hnQ[(t128 * 8 + h) * 2 + 1]);
      const float kda = sqrtf(hnK[(t128 * 8 + h) * 2]), kdb = sqrtf(hnK[(t128 * 8 + h) * 2 + 1]);
      float ka = fmaxf(hnK[(lane * 8 + h) * 2], hnK[((lane + 64) * 8 + h) * 2]), kb = fmaxf(hnK[(lane * 8 + h) * 2 + 1], hnK[((lane + 64) * 8 + h) * 2 + 1]);
      ka = sqrtf(wave_max(ka)); kb = sqrtf(wave_max(kb));
      nb = 1.02f * (qa * (ka + kda) + qb * (kb + kdb)) + 2.0f; }
    const float l2q0 = __shfl(cq, 0);
    AttnSt st; st.m = -INFINITY; st.l = 0.f;
#pragma unroll
    for (int r = 0; r < 16; ++r) { st.o0[r] = 0.f; st.o1[r] = 0.f; }
    float sub = 0.f;
    for (int j = jd; j >= 0; --j) {
        const bool diag = (j == jd);
        if (!diag) {
            if (nb + l2q0 + sub < -152.f) break;
            sub += TT2[j * 8 + h];
        }
        bf16x8 kf[8], vf[8];
        const bf16_t* kb = Kb + (size_t)(64 * j + ql) * 512 + h * 64 + 8 * hi;
#pragma unroll
        for (int half = 0; half < 2; ++half)
#pragma unroll
            for (int d0 = 0; d0 < 4; ++d0) kf[half * 4 + d0] = *(const bf16x8*)(kb + (size_t)half * 32 * 512 + 16 * d0);
        const bf16_t* vb = Vt + ((size_t)(h * 256 + j) * 64 + ql) * 64 + 8 * hi;
#pragma unroll
        for (int dh = 0; dh < 2; ++dh)
#pragma unroll
            for (int ks = 0; ks < 4; ++ks) vf[dh * 4 + ks] = *(const bf16x8*)(vb + dh * 32 * 64 + 16 * ks);
        const float cqs = cq + sub;
        f32x16 p0, p1;
#pragma unroll
        for (int g = 0; g < 4; ++g) {
            const f32x4 c0 = *(const f32x4*)(lh + 64 * j + 8 * g + 4 * hi), c1 = *(const f32x4*)(lh + 64 * j + 32 + 8 * g + 4 * hi);
#pragma unroll
            for (int e = 0; e < 4; ++e) {
                float b0 = cqs - c0[e], b1 = cqs - c1[e];
                if (diag) { const int kv = 8 * g + 4 * hi + e; if (kv > qoff + ql) b0 = -INFINITY; if (kv + 32 > qoff + ql) b1 = -INFINITY; }
                p0[4 * g + e] = b0; p1[4 * g + e] = b1;
            }
        }
        attn_step<false>(st, qr, kf, vf, p0, p1, wsf, ql, hi);
    }
    attn_finish(st, OA + (size_t)q0 * 512 + h * 64, wsf, ql, hi);
}

__device__ __forceinline__ bf16x8 ldk_f32(const float* p) { const f32x4 a = *(const f32x4*)p, b = *(const f32x4*)(p + 4); return __builtin_bit_cast(bf16x8, pack8(a, b)); }
__device__ __forceinline__ bf16x8 ldv_f32(const float* p) {
    u32x4 w; w.x = cvtpk(p[0], p[512]); w.y = cvtpk(p[1024], p[1536]); w.z = cvtpk(p[8 * 512], p[9 * 512]); w.w = cvtpk(p[10 * 512], p[11 * 512]);
    return __builtin_bit_cast(bf16x8, w);
}
__device__ __forceinline__ void attn_sample_item(int b, int h, const bf16_t* Qb, const float* ck, const float* cv, const float* clf, const float* out, bf16_t* OA, LAS float* wsf, int lane) {
    const int ql = lane & 31, hi = lane >> 5;
    bf16x8 qr[4];
    { const bf16_t* qp = Qb + (size_t)(SEQ + b * 32 + ql) * 512 + h * 64 + 8 * hi;
#pragma unroll
      for (int d0 = 0; d0 < 4; ++d0) qr[d0] = *(const bf16x8*)(qp + 16 * d0); }
    float cq = out[O_LFS + (size_t)(b * 32 + ql) * 8 + h] * LOG2E;
#pragma unroll
    for (int o = 1; o < 32; o <<= 1) { const float t = __shfl_up(cq, o, 32); if (ql >= o) cq += t; }
    AttnSt st; st.m = -INFINITY; st.l = 0.f;
#pragma unroll
    for (int r = 0; r < 16; ++r) { st.o0[r] = 0.f; st.o1[r] = 0.f; }
    bf16x8 kf[8], vf[8];
    {
        if (hi == 0) wsf[ql] = cq;
        asm volatile("s_waitcnt lgkmcnt(0)" ::: "memory");
        f32x16 p0, p1;
#pragma unroll
        for (int g = 0; g < 4; ++g) {
            const f32x4 c0 = *(const LAS f32x4*)(wsf + 8 * g + 4 * hi);
#pragma unroll
            for (int e = 0; e < 4; ++e) { const int kv = 8 * g + 4 * hi + e; p0[4 * g + e] = (kv > ql) ? -INFINITY : cq - c0[e]; p1[4 * g + e] = 0.f; }
        }
        asm volatile("s_waitcnt lgkmcnt(0)" ::: "memory");
        const float* kb = out + O_KS + ((size_t)(b * 32 + ql) * 8 + h) * 64 + 8 * hi;
        const float* vb = out + O_VS + ((size_t)(b * 32 + 4 * hi) * 8 + h) * 64 + ql;
#pragma unroll
        for (int d0 = 0; d0 < 4; ++d0) kf[d0] = ldk_f32(kb + 16 * d0);
#pragma unroll
        for (int dh = 0; dh < 2; ++dh)
#pragma unroll
            for (int ks = 0; ks < 2; ++ks) vf[dh * 4 + ks] = ldv_f32(vb + dh * 32 + (size_t)ks * 16 * 512);
        attn_step<true>(st, qr, kf, vf, p0, p1, wsf, ql, hi);
    }
    float carry = 0.f;
    for (int j = PAST / 64 - 1; j >= 0; --j) {
        const float lfc = clf[((size_t)b * PAST + 64 * j + lane) * 8 + h] * LOG2E;
        float inc = lfc;
#pragma unroll
        for (int o = 1; o < 64; o <<= 1) { const float t = __shfl_down(inc, o); if (lane + o < 64) inc += t; }
        wsf[64 + lane] = inc - lfc + carry;
        carry += __shfl(inc, 0);
        asm volatile("s_waitcnt lgkmcnt(0)" ::: "memory");
#pragma unroll 1
        for (int half = 1; half >= 0; --half) {
            f32x16 p0, p1;
#pragma unroll
            for (int g = 0; g < 4; ++g) {
                const f32x4 c0 = *(const LAS f32x4*)(wsf + 64 + 32 * half + 8 * g + 4 * hi);
#pragma unroll
                for (int e = 0; e < 4; ++e) { p0[4 * g + e] = cq + c0[e]; p1[4 * g + e] = 0.f; }
            }
            const float* kb = ck + (((size_t)b * PAST + 64 * j + 32 * half + ql) * 8 + h) * 64 + 8 * hi;
            const float* vb = cv + (((size_t)b * PAST + 64 * j + 32 * half + 4 * hi) * 8 + h) * 64 + ql;
#pragma unroll
            for (int d0 = 0; d0 < 4; ++d0) kf[d0] = ldk_f32(kb + 16 * d0);
#pragma unroll
            for (int dh = 0; dh < 2; ++dh)
#pragma unroll
                for (int ks = 0; ks < 2; ++ks) vf[dh * 4 + ks] = ldv_f32(vb + dh * 32 + (size_t)ks * 16 * 512);
            attn_step<true>(st, qr, kf, vf, p0, p1, wsf, ql, hi);
        }
    }
    attn_finish(st, OA + (size_t)(SEQ + b * 32) * 512 + h * 64, wsf, ql, hi);
}


constexpr int AT_SLOT = 17408, AT_V = 8192, AT_X = 16384;
#define AT_WAITV(n) asm volatile("s_waitcnt vmcnt(" #n ") lgkmcnt(0)" ::: "memory")
__device__ __forceinline__ void attn_prompt_block(int qb, int h, const bf16_t* Qb, const bf16_t* Kb, const bf16_t* Vt, const u32x4* KX, const float* LH2, const float* TT2,
                                                  const float* hnQ, const float* hnK, bf16_t* OA, LAS unsigned char* lds, LAS float* wsf, LAS float* offs, int wave, int lane) {
    const int ql = lane & 31, hi = lane >> 5, wh = wave >> 1;
    const int q0 = 256 * qb + 32 * wave, qoff = (32 * wave) & 63;
    bf16x8 qr[4];
    { const bf16_t* qp = Qb + (size_t)(q0 + ql) * 512 + h * 64 + 8 * hi;
#pragma unroll
      for (int d0 = 0; d0 < 4; ++d0) qr[d0] = *(const bf16x8*)(qp + 16 * d0); }
    const float* lh = LH2 + (size_t)h * SEQ;
    const float cq = lh[q0 + ql];
    float nbL, nb2;
    { const int ta = 2 * qb, tb2 = 2 * qb + 1;
      const float qa = sqrtf(fmaxf(hnQ[(ta * 8 + h) * 2], hnQ[(tb2 * 8 + h) * 2])), qbn = sqrtf(fmaxf(hnQ[(ta * 8 + h) * 2 + 1], hnQ[(tb2 * 8 + h) * 2 + 1]));
      const float kda = sqrtf(fmaxf(hnK[(ta * 8 + h) * 2], hnK[(tb2 * 8 + h) * 2])), kdb = sqrtf(fmaxf(hnK[(ta * 8 + h) * 2 + 1], hnK[(tb2 * 8 + h) * 2 + 1]));
      float ka = fmaxf(hnK[(lane * 8 + h) * 2], hnK[((lane + 64) * 8 + h) * 2]), kb = fmaxf(hnK[(lane * 8 + h) * 2 + 1], hnK[((lane + 64) * 8 + h) * 2 + 1]);
      ka = sqrtf(wave_max(ka)); kb = sqrtf(wave_max(kb));
      nbL = 1.02f * (qa * (ka + kda) + qbn * (kb + kdb)) + 2.0f + lh[256 * qb];
      nb2 = 1.02f * (qa * ka + qbn * kb) + 2.0f + lh[256 * qb]; }
    const float tb0 = TT2[(4 * qb) * 8 + h], tb1 = TT2[(4 * qb + 1) * 8 + h], tb2v = TT2[(4 * qb + 2) * 8 + h];
    const float pre1 = tb0, pre2 = tb0 + tb1, pre3 = pre2 + tb2v;
    const float prew = (wh == 0) ? 0.f : (wh == 1) ? pre1 : (wh == 2) ? pre2 : pre3;
    int count = 4 * qb;
    { float carry = 0.f;
      for (int base = 0; base < 4 * qb; base += 64) {
          const int i = base + lane, j = 4 * qb - 1 - i;
          const float tt = (j >= 0) ? TT2[j * 8 + h] : 0.f;
          float inc = tt;
#pragma unroll
          for (int o = 1; o < 64; o <<= 1) { const float t = __shfl_up(inc, o); if (lane >= o) inc += t; }
          const float sexcl = inc - tt + carry;
          const bool cond = (j < 0) || (nbL + sexcl < -152.f);
          if (j >= 0) offs[i] = inc + carry;
          const unsigned long long bal = __ballot(cond);
          if (bal) { count = base + (int)__ffsll((long long)bal) - 1; break; }
          carry += __shfl(inc, 63);
      } }
    const int NT = 4 + count, jmax = 4 * qb + 3;
    const int r8 = 8 * wave + (lane >> 3), cc = (lane & 7) ^ ((r8 >> 1) & 7);
    const bf16_t* ksrc = Kb + (size_t)r8 * 512 + h * 64 + 8 * cc;
    const bf16_t* vsrc = Vt + ((size_t)(h * 256) * 64 + r8) * 64 + 8 * cc;
    const u32x4* xsrc = KX + (size_t)h * SEQ + lane;
    const int swz = (ql >> 1) & 7;
    int fo[4];
#pragma unroll
    for (int d0 = 0; d0 < 4; ++d0) fo[d0] = ql * 128 + 16 * ((2 * d0 + hi) ^ swz);
#define AT_DMA(tt_) do { const int j_ = jmax - (tt_); LAS unsigned char* sl_ = lds + ((tt_) % 3) * AT_SLOT; \
        __builtin_amdgcn_global_load_lds((const unsigned*)(ksrc + (size_t)j_ * 64 * 512), (LAS unsigned*)(sl_ + wave * 1024), 16, 0, 0); \
        __builtin_amdgcn_global_load_lds((const unsigned*)(vsrc + (size_t)j_ * 4096), (LAS unsigned*)(sl_ + AT_V + wave * 1024), 16, 0, 0); \
        if (wave == 0) __builtin_amdgcn_global_load_lds((const unsigned*)(xsrc + (size_t)j_ * 64), (LAS unsigned*)(sl_ + AT_X), 16, 0, 0); } while (0)
    AT_DMA(0); AT_DMA(1);
    AttnSt st; st.m = -INFINITY; st.l = 0.f;
#pragma unroll
    for (int r = 0; r < 16; ++r) { st.o0[r] = 0.f; st.o1[r] = 0.f; }
    const int jd = 4 * qb + wh;
    float mmin = 0.f;
    for (int t = 0; t < NT; ++t) {
        if (t + 1 < NT) { if (wave == 0) AT_WAITV(3); else AT_WAITV(2); } else AT_WAITV(0);
        __builtin_amdgcn_s_barrier();
        if (t >= 4) {
            if (t == 4) { const LAS float* mw = offs + 256; mmin = fminf(fminf(fminf(mw[0], mw[1]), fminf(mw[2], mw[3])), fminf(fminf(mw[4], mw[5]), fminf(mw[6], mw[7]))); }
            const float sex = (t == 4) ? 0.f : offs[t - 5];
            if (nb2 + sex - mmin < -152.f) break;
        }
        if (t + 2 < NT) AT_DMA(t + 2);
        const int j = jmax - t;
        if (j > jd) continue;
        float off;
        if (t < 4) { const int kk = 3 - t; const float prek = (kk == 0) ? 0.f : (kk == 1) ? pre1 : (kk == 2) ? pre2 : pre3; off = prew - prek; }
        else off = prew + offs[t - 4];
        const float cqs = cq + off;
        const LAS unsigned char* sl = lds + (t % 3) * AT_SLOT;
        f32x16 p0, p1;
        if (j == jd) {
#pragma unroll
            for (int r = 0; r < 16; ++r) { const int kv = crow(r, hi); p0[r] = (kv > qoff + ql) ? -INFINITY : cqs; p1[r] = (kv + 32 > qoff + ql) ? -INFINITY : cqs; }
        } else {
#pragma unroll
            for (int r = 0; r < 16; ++r) { p0[r] = cqs; p1[r] = cqs; }
        }
        { bf16x8 x0 = *(const LAS bf16x8*)(sl + AT_X + 16 * ql), x1 = *(const LAS bf16x8*)(sl + AT_X + 16 * (ql + 32));
          u32x4 qxw; qxw.x = hi ? 0u : 0xBF80BF80u; qxw.y = 0u; qxw.z = 0u; qxw.w = 0u;
          const bf16x8 qxv = __builtin_bit_cast(bf16x8, qxw);
          p0 = MFMA32(x0, qxv, p0); p1 = MFMA32(x1, qxv, p1); }
        bf16x8 kf[8], vf[8];
        int f0 = fo[0], f1 = fo[1], f2 = fo[2], f3 = fo[3];
        asm volatile("" : "+v"(f0), "+v"(f1), "+v"(f2), "+v"(f3));
        const int fq4[4] = {f0, f1, f2, f3};
#pragma unroll
        for (int half = 0; half < 2; ++half)
#pragma unroll
            for (int d0 = 0; d0 < 4; ++d0) { kf[half * 4 + d0] = *(const LAS bf16x8*)(sl + fq4[d0] + half * 4096); vf[half * 4 + d0] = *(const LAS bf16x8*)(sl + fq4[d0] + (AT_V + half * 4096)); }
        attn_step<false>(st, qr, kf, vf, p0, p1, wsf, ql, hi);
        if (j == jd) { const float wm = -wave_max(-st.m); if (lane == 0) offs[256 + wave] = wm; }
    }
#undef AT_DMA
    attn_finish(st, OA + (size_t)q0 * 512 + h * 64, wsf, ql, hi);
}

__device__ __forceinline__ void attn_sample_block(int b, int h, const bf16_t* Qb, const float* ck, const float* cv, const float* clf, const float* out, bf16_t* OA,
                                                  LAS unsigned char* lds, LAS float* wsf, int wave, int lane, int tid) {
    const int ql = lane & 31, hi = lane >> 5;
    bf16x8 qr[4];
    { const bf16_t* qp = Qb + (size_t)(SEQ + b * 32 + ql) * 512 + h * 64 + 8 * hi;
#pragma unroll
      for (int d0 = 0; d0 < 4; ++d0) qr[d0] = *(const bf16x8*)(qp + 16 * d0); }
    float cq = out[O_LFS + (size_t)(b * 32 + ql) * 8 + h] * LOG2E;
#pragma unroll
    for (int o = 1; o < 32; o <<= 1) { const float t = __shfl_up(cq, o, 32); if (ql >= o) cq += t; }
    LAS float* segt = (LAS float*)(lds + 68608);
    const int s0 = 128 * wave;
    const float lf0 = clf[((size_t)b * PAST + s0 + 2 * lane) * 8 + h] * LOG2E, lf1 = clf[((size_t)b * PAST + s0 + 2 * lane + 1) * 8 + h] * LOG2E;
    float inc = lf0 + lf1;
#pragma unroll
    for (int o = 1; o < 64; o <<= 1) { const float t = __shfl_down(inc, o); if (lane + o < 64) inc += t; }
    if (lane == 0) segt[wave] = inc;
    __syncthreads();
    float carry = 0.f;
#pragma unroll
    for (int w2 = 1; w2 < 8; ++w2) if (w2 > wave) carry += segt[w2];
    { const float s1 = inc - lf0 - lf1 + carry; *(LAS f32x2*)(wsf + 128 + 2 * lane) = (f32x2){s1 + lf1, s1}; }
    asm volatile("s_waitcnt lgkmcnt(0)" ::: "memory");
    AttnSt st; st.m = -INFINITY; st.l = 0.f;
#pragma unroll
    for (int r = 0; r < 16; ++r) { st.o0[r] = 0.f; st.o1[r] = 0.f; }
    bf16x8 kf[8], vf[8];
#pragma unroll 1
    for (int ht = 3; ht >= 0; --ht) {
        f32x16 p0, p1;
#pragma unroll
        for (int g = 0; g < 4; ++g) {
            const f32x4 c0 = *(const LAS f32x4*)(wsf + 128 + 32 * ht + 8 * g + 4 * hi);
#pragma unroll
            for (int e = 0; e < 4; ++e) { p0[4 * g + e] = cq + c0[e]; p1[4 * g + e] = 0.f; }
        }
        const float* kb = ck + (((size_t)b * PAST + s0 + 32 * ht + ql) * 8 + h) * 64 + 8 * hi;
        const float* vb = cv + (((size_t)b * PAST + s0 + 32 * ht + 4 * hi) * 8 + h) * 64 + ql;
#pragma unroll
        for (int d0 = 0; d0 < 4; ++d0) kf[d0] = ldk_f32(kb + 16 * d0);
#pragma unroll
        for (int dh = 0; dh < 2; ++dh)
#pragma unroll
            for (int ks = 0; ks < 2; ++ks) vf[dh * 4 + ks] = ldv_f32(vb + dh * 32 + (size_t)ks * 16 * 512);
        attn_step<true>(st, qr, kf, vf, p0, p1, wsf, ql, hi);
    }
    if (wave == 7) {
        if (hi == 0) wsf[ql] = cq;
        asm volatile("s_waitcnt lgkmcnt(0)" ::: "memory");
        f32x16 p0, p1;
#pragma unroll
        for (int g = 0; g < 4; ++g) {
            const f32x4 c0 = *(const LAS f32x4*)(wsf + 8 * g + 4 * hi);
#pragma unroll
            for (int e = 0; e < 4; ++e) { const int kv = 8 * g + 4 * hi + e; p0[4 * g + e] = (kv > ql) ? -INFINITY : cq - c0[e]; p1[4 * g + e] = 0.f; }
        }
        asm volatile("s_waitcnt lgkmcnt(0)" ::: "memory");
        const float* kb = out + O_KS + ((size_t)(b * 32 + ql) * 8 + h) * 64 + 8 * hi;
        const float* vb = out + O_VS + ((size_t)(b * 32 + 4 * hi) * 8 + h) * 64 + ql;
#pragma unroll
        for (int d0 = 0; d0 < 4; ++d0) kf[d0] = ldk_f32(kb + 16 * d0);
#pragma unroll
        for (int dh = 0; dh < 2; ++dh)
#pragma unroll
            for (int ks = 0; ks < 2; ++ks) vf[dh * 4 + ks] = ldv_f32(vb + dh * 32 + (size_t)ks * 16 * 512);
        attn_step<true>(st, qr, kf, vf, p0, p1, wsf, ql, hi);
    }
    LAS float* po = (LAS float*)(lds + wave * 8448);
    const float lt = st.l + __shfl_xor(st.l, 32);
#pragma unroll
    for (int r = 0; r < 16; ++r) { po[crow(r, hi) * 64 + ql] = st.o0[r]; po[crow(r, hi) * 64 + 32 + ql] = st.o1[r]; }
    if (hi == 0) { po[2048 + ql] = st.m; po[2080 + ql] = lt; }
    __syncthreads();
    { const int q = tid >> 4, d4 = (tid & 15) * 4;
      float mw[8], M = -INFINITY;
#pragma unroll
      for (int w2 = 0; w2 < 8; ++w2) { mw[w2] = ((const LAS float*)(lds + w2 * 8448))[2048 + q]; M = fmaxf(M, mw[w2]); }
      float L = 0.f; f32x4 O = (f32x4){0.f, 0.f, 0.f, 0.f};
#pragma unroll
      for (int w2 = 0; w2 < 8; ++w2) { const LAS float* pw = (const LAS float*)(lds + w2 * 8448); const float wg = __builtin_amdgcn_exp2f(mw[w2] - M);
          L += wg * pw[2080 + q]; O = O + *(const LAS f32x4*)(pw + q * 64 + d4) * wg; }
      const float inv = 1.0f / L;
      u32x2 w; w.x = cvtpk(O[0] * inv, O[1] * inv); w.y = cvtpk(O[2] * inv, O[3] * inv);
      *(u32x2*)(OA + (size_t)(SEQ + b * 32 + q) * 512 + h * 64 + d4) = w; }
    __syncthreads();
}

constexpr int PL_STRIDE = 136;
template <int W>
__device__ __forceinline__ void pool_fill(int rt, int g, const float* P, const float* state_pool, LAS bf16_t* At, int tid) {
    const int cq = tid & 31, rg = tid >> 5;
    const int row0 = rt * 128 + 8 * rg, col = g * 128 + 4 * cq;
    const bool prompt = rt < 128;
    const float* pb; const float* hb; int nh;
    if (prompt) { pb = P + (size_t)row0 * 512 + col; hb = nullptr; nh = row0; }
    else { const int rs = row0 - SEQ, b = rs >> 5, tl0 = rs & 31; pb = P + (size_t)row0 * 512 + col; hb = state_pool + (size_t)(b * 15 + 15 + tl0) * 512 + col; nh = tl0; }
    auto ld = [&](int rr) -> f32x4 {
        if (rr + nh >= 0) return *(const f32x4*)(pb + (ptrdiff_t)rr * 512);
        if (hb) return *(const f32x4*)(hb + (ptrdiff_t)rr * 512);
        return (f32x4){0.f, 0.f, 0.f, 0.f};
    };
    f32x4 s = ld(-(W - 1));
#pragma unroll
    for (int i = 1; i < W - 1; ++i) s = s + ld(i - (W - 1));
    f32x4 cur = ld(0);
    s = s + cur;
#pragma unroll
    for (int i = 0; i < 8; ++i) {
        if (i > 0) { cur = ld(i); s = s + (cur - ld(i - W)); }
        float cnt = (float)W;
        if (prompt) { const int t = row0 + i; cnt = (float)((t + 1 < W) ? (t + 1) : W); }
        const f32x4 d = s * __builtin_amdgcn_rcpf(cnt) - cur;
        u32x2 w; w.x = cvtpk(d[0], d[1]); w.y = cvtpk(d[2], d[3]);
        *(LAS u32x2*)(At + (8 * rg + i) * PL_STRIDE + 4 * cq) = w;
    }
}
__device__ __forceinline__ void pool_item(int rt, int g, const float* P, const float* state_pool, const bf16_t* Wpg, const float* pool_scale, bf16_t* OP, LAS unsigned char* lds, int tid) {
    LAS bf16_t* At = (LAS bf16_t*)lds; LAS bf16_t* Bt = At + 128 * PL_STRIDE;
    if (g == 0) pool_fill<2>(rt, g, P, state_pool, At, tid);
    else if (g == 1) pool_fill<4>(rt, g, P, state_pool, At, tid);
    else if (g == 2) pool_fill<8>(rt, g, P, state_pool, At, tid);
    else pool_fill<16>(rt, g, P, state_pool, At, tid);
#pragma unroll
    for (int i = 0; i < 4; ++i) { const int idx = tid + 512 * i, n = idx >> 4, kc = (idx & 15) * 8;
        *(LAS u32x4*)(Bt + n * PL_STRIDE + kc) = *(const u32x4*)(Wpg + (size_t)g * 16384 + n * 128 + kc); }
    __syncthreads();
    const int wid = tid >> 6, lane = tid & 63, ql = lane & 31, hi = lane >> 5;
    const int r0 = 32 * (wid & 3), c0 = 64 * (wid >> 2);
    f32x16 a0, a1;
#pragma unroll
    for (int r = 0; r < 16; ++r) { a0[r] = 0.f; a1[r] = 0.f; }
#pragma unroll
    for (int ks = 0; ks < 8; ++ks) {
        const bf16x8 af = *(const LAS bf16x8*)(At + (r0 + ql) * PL_STRIDE + 16 * ks + 8 * hi);
        const bf16x8 b0 = *(const LAS bf16x8*)(Bt + (c0 + ql) * PL_STRIDE + 16 * ks + 8 * hi);
        const bf16x8 b1 = *(const LAS bf16x8*)(Bt + (c0 + 32 + ql) * PL_STRIDE + 16 * ks + 8 * hi);
        a0 = MFMA32(af, b0, a0); a1 = MFMA32(af, b1, a1);
    }
    const float s0 = pool_scale[g * 128 + c0 + ql], s1 = pool_scale[g * 128 + c0 + 32 + ql];
#pragma unroll
    for (int r = 0; r < 16; ++r) {
        bf16_t* o = OP + (size_t)(rt * 128 + r0 + crow(r, hi)) * 512 + g * 128 + c0 + ql;
        o[0] = cvt1(a0[r] * s0); o[32] = cvt1(a1[r] * s1);
    }
    __syncthreads();
}

__device__ __forceinline__ void tr_item(const float* W, int ldw, int Kdim, bf16_t* WT, int drow0, int k0, int n0src, LAS float* scr, int lane) {
#pragma unroll 8
    for (int i = 0; i < 32; ++i) { const int kk = 2 * i + (lane >> 5); scr[kk * 33 + (lane & 31)] = W[(size_t)(k0 + kk) * ldw + n0src + (lane & 31)]; }
    asm volatile("s_waitcnt lgkmcnt(0)" ::: "memory");
    const int c = lane & 7;
#pragma unroll
    for (int j = 0; j < 4; ++j) { const int n = (lane >> 3) + 8 * j; const LAS float* s = scr + (8 * c) * 33 + n;
        u32x4 o; o.x = cvtpk(s[0 * 33], s[1 * 33]); o.y = cvtpk(s[2 * 33], s[3 * 33]); o.z = cvtpk(s[4 * 33], s[5 * 33]); o.w = cvtpk(s[6 * 33], s[7 * 33]);
        *(u32x4*)(WT + (size_t)(drow0 + n) * Kdim + k0 + 8 * c) = o; }
    asm volatile("s_waitcnt lgkmcnt(0)" ::: "memory");
}

#define XB_TMO      128
#define XB_XCNT(j)  (256  + 64 * (j))
#define XB_XSUB(j)  (1280 + 64 * (j))
#define XB_XGEN(j)  (2304 + 64 * (j))
#define XB_TOP      3328
#define XB_TOPGEN   3392
#define XCD_BAR_WORDS 3456
#define XB_SPIN_CAP (1u << 22)
#define BAR_MAGIC 0x5EEDBA55u
__device__ __forceinline__ unsigned xb_ld(unsigned* p)              { return __hip_atomic_load(p, __ATOMIC_RELAXED, __HIP_MEMORY_SCOPE_AGENT); }
__device__ __forceinline__ unsigned xb_add(unsigned* p, unsigned v) { return __hip_atomic_fetch_add(p, v, __ATOMIC_RELAXED, __HIP_MEMORY_SCOPE_AGENT); }
__device__ __forceinline__ unsigned xb_xcc_id() { return (unsigned)__builtin_amdgcn_s_getreg((3 << 11) | 20) & 0xFu; }
#define XB_SPIN(cond, bar) do { unsigned _sp = 0; while (cond) { __builtin_amdgcn_s_sleep(1); \
    if ((++_sp & 255u) == 0u) { if (xb_ld(&(bar)[XB_TMO])) break; if (_sp > XB_SPIN_CAP) { atomicAdd(&(bar)[XB_TMO], 1u); break; } } } } while (0)
struct XcdBarrier { unsigned* bar; unsigned x; volatile LAS unsigned* st; };
__device__ __forceinline__ XcdBarrier xcd_barrier_post(unsigned* bar, volatile LAS unsigned* st) {
    XcdBarrier b; b.bar = bar; b.x = xb_xcc_id(); b.st = st;
    if (threadIdx.x == 0) (void)xb_add(&bar[XB_XCNT(b.x)], 1u);
    return b;
}
__device__ __forceinline__ void xcd_barrier_complete(unsigned* bar, unsigned x, unsigned& nloc, unsigned& nx) {
    const unsigned G = gridDim.x * gridDim.y * gridDim.z;
    unsigned sum, cnt, mine, sp = 0u;
    for (;;) {
        sum = 0u; cnt = 0u; mine = 0u;
#pragma unroll
        for (unsigned j = 0; j < 16; ++j) { const unsigned c = xb_ld(&bar[XB_XCNT(j)]); sum += c; cnt += (c > 0u) ? 1u : 0u; mine = (j == x) ? c : mine; }
        if (sum == G) break;
        __builtin_amdgcn_s_sleep(1);
        if ((++sp & 255u) == 0u) { if (xb_ld(&bar[XB_TMO])) break; if (sp > XB_SPIN_CAP) { atomicAdd(&bar[XB_TMO], 1u); break; } }
    }
    nloc = mine > 0u ? mine : 1u; nx = cnt > 0u ? cnt : 1u;
}
__device__ __forceinline__ void xcd_barrier(const XcdBarrier& b) {
    asm volatile("s_waitcnt vmcnt(0)" ::: "memory");
    __syncthreads();
    if (threadIdx.x == 0) {
        unsigned* bar = b.bar;
        __builtin_amdgcn_s_waitcnt(0);
        unsigned nloc = b.st[0], nx = b.st[1];
        if (nloc == 0u) { xcd_barrier_complete(bar, b.x, nloc, nx); b.st[0] = nloc; b.st[1] = nx; }
        const unsigned old = xb_add(&bar[XB_XSUB(b.x)], 1u);
        const unsigned gen = old / nloc;
        if (old + 1u == (gen + 1u) * nloc) {
            __builtin_amdgcn_fence(__ATOMIC_RELEASE, "agent");
            asm volatile("s_waitcnt vmcnt(0)" ::: "memory");
            const unsigned og = xb_add(&bar[XB_TOP], 1u);
            const unsigned tg = og / nx;
            if (og + 1u == (tg + 1u) * nx) xb_add(&bar[XB_TOPGEN], 1u);
            else XB_SPIN(xb_ld(&bar[XB_TOPGEN]) == tg, bar);
            __builtin_amdgcn_fence(__ATOMIC_ACQUIRE, "agent");
            xb_add(&bar[XB_XGEN(b.x)], 1u);
            asm volatile("s_waitcnt vmcnt(0)" ::: "memory");
        } else {
            XB_SPIN(xb_ld(&bar[XB_XGEN(b.x)]) == gen, bar);
            __builtin_amdgcn_fence(__ATOMIC_ACQUIRE, "agent");
            asm volatile("s_waitcnt vmcnt(0)" ::: "memory");
        }
    }
    __syncthreads();
}

struct Params {
    const float* in[20];
    float* out;
    unsigned char* ws;
    int ph_lo, ph_hi;
};

constexpr int LDS_BYTES = 147456;
constexpr int NTHREADS = 512;

__global__ void __launch_bounds__(NTHREADS, 2) fwd_kernel(Params p) {
    extern __shared__ __attribute__((aligned(16))) unsigned char lds_raw[];
    LAS unsigned char* lds = (LAS unsigned char*)lds_raw;
    const int tid = threadIdx.x, lane = tid & 63, wave = __builtin_amdgcn_readfirstlane(tid >> 6);
    const int G = gridDim.x, bx = blockIdx.x;
    unsigned* barw = (unsigned*)(p.ws + WS_BAR);
    volatile LAS unsigned* bst = (volatile LAS unsigned*)(lds + LDS_BYTES - 64);
    XcdBarrier xbar; xbar.bar = barw; xbar.x = 0; xbar.st = bst;
    if (p.ph_lo == -12345) cg::this_grid().sync();
    unsigned* startw = (unsigned*)(p.ws + WS_BAR + 16384);
    if (p.ph_hi - p.ph_lo > 1) {
        if (tid < 2) bst[tid] = 0u;
        if (bx == 0) {
            for (int i = tid; i < XCD_BAR_WORDS; i += NTHREADS) barw[i] = 0u;
            asm volatile("s_waitcnt vmcnt(0)" ::: "memory"); __syncthreads();
            if (tid == 0) { __builtin_amdgcn_fence(__ATOMIC_RELEASE, "agent"); asm volatile("s_waitcnt vmcnt(0)" ::: "memory"); __hip_atomic_store(startw, BAR_MAGIC, __ATOMIC_RELAXED, __HIP_MEMORY_SCOPE_AGENT); }
        } else if (tid == 0) {
            while (__hip_atomic_load(startw, __ATOMIC_RELAXED, __HIP_MEMORY_SCOPE_AGENT) != BAR_MAGIC) __builtin_amdgcn_s_sleep(2);
            __builtin_amdgcn_fence(__ATOMIC_ACQUIRE, "agent");
        }
        __syncthreads();
        xbar = xcd_barrier_post(barw, bst);
    }
    const int gw = bx * 8 + wave, NGW = G * 8;
    unsigned char* ws = p.ws; float* out = p.out;
    const float* x_prompt = p.in[0]; const float* x_sample = p.in[1]; const float* cache_k = p.in[2]; const float* cache_v = p.in[3];
    const float* cache_logf = p.in[4]; const float* state_pool = p.in[5]; const float* norm_mix = p.in[6]; const float* w_in = p.in[7];
    const float* b_forget = p.in[8]; const float* w_pool_group = p.in[9]; const float* pool_scale = p.in[10]; const float* w_branch_pool = p.in[11];
    const float* w_branch_attn = p.in[12]; const float* b_gate = p.in[13]; const float* w_out = p.in[14]; const float* norm_ffn = p.in[15];
    const float* w_ffn_gate = p.in[16]; const float* w_ffn_up = p.in[17]; const float* w_ffn_down = p.in[18]; const float* norm_final = p.in[19];
    float* hnQ = (float*)(ws + WS_CTL + CTL_HNQ); float* hnK = (float*)(ws + WS_CTL + CTL_HNK);
    float* rss1 = (float*)(ws + WS_CTL + CTL_RSS1); float* rss2 = (float*)(ws + WS_CTL + CTL_RSS2);
    unsigned* ctr = (unsigned*)(ws + WS_CTL + CTL_CTR); unsigned* flag3 = ctr + 16; unsigned* flag4 = ctr + 32;
    bf16_t* X2b = (bf16_t*)(ws + WS_OP);
    float* PA = (float*)(ws + WS_Q); float* PB = (float*)(ws + WS_OP);
    float* TT2 = (float*)(ws + WS_TT); float* LH2 = (float*)(ws + WS_LH); u32x4* KX = (u32x4*)(ws + WS_KX);
    bf16_t* W1t = (bf16_t*)(ws + WS_W1); bf16_t* Wbp = (bf16_t*)(ws + WS_WBP); bf16_t* Wba = (bf16_t*)(ws + WS_WBA); bf16_t* Wo = (bf16_t*)(ws + WS_WO);
    bf16_t* Wgu = (bf16_t*)(ws + WS_WGU); bf16_t* Wd = (bf16_t*)(ws + WS_WD); bf16_t* Wpg = (bf16_t*)(ws + WS_WPG);
    bf16_t* XN = (bf16_t*)(ws + WS_XN); bf16_t* MG = (bf16_t*)(ws + WS_XN); bf16_t* Gt = (bf16_t*)(ws + WS_G); bf16_t* HN = (bf16_t*)(ws + WS_G);
    float* PART = (float*)(ws + WS_XN);
    float* Pf = (float*)(ws + WS_P); bf16_t* Qb = (bf16_t*)(ws + WS_Q); bf16_t* Kb = (bf16_t*)(ws + WS_K); bf16_t* Vt = (bf16_t*)(ws + WS_V);
    bf16_t* OP = (bf16_t*)(ws + WS_OP); bf16_t* OA = (bf16_t*)(ws + WS_OA); bf16_t* Tf = (bf16_t*)(ws + WS_T); bf16_t* HF = (bf16_t*)(ws + WS_HF);
    const int lo = p.ph_lo, hi_ph = p.ph_hi;
#define IN(k) (lo <= (k) && (k) < hi_ph)
#define SEAM(k) do { if (IN(k) && IN((k) + 1)) xcd_barrier(xbar); } while (0)

    if (IN(0)) {
        for (size_t i = (size_t)bx * NTHREADS + tid; i < CTL_ZERO_END / 4; i += (size_t)G * NTHREADS) ((unsigned*)(ws + WS_CTL))[i] = 0u;
        LAS float* wf = (LAS float*)(lds + 73728);
        for (int i = tid; i < 8192; i += NTHREADS) wf[i] = w_in[(size_t)(i >> 3) * DIN + 2048 + (i & 7)];
        LAS float* scr = (LAS float*)(lds + wave * 8704);
        constexpr int I1 = 16 * 128, I8 = 32;
        for (int it = gw; it < I1 + I8; it += NGW) {
            int r = it;
            if (r < I1) { const int kb = r / 128, nb = r % 128, n0 = 32 * nb; tr_item(w_in, DIN, 1024, W1t, n0, 64 * kb, n0 < 2048 ? n0 : n0 + 8, scr, lane); continue; } r -= I1;
            { const int g = r >> 3, kb = (r >> 2) & 1, nb = r & 3; tr_item(w_pool_group + (size_t)g * 16384, 128, 128, Wpg + (size_t)g * 16384, 32 * nb, 64 * kb, 32 * nb, scr, lane); }
        }
        __syncthreads();
        f32x4 wfa[4][4], wfb[4][4];
#pragma unroll
        for (int j = 0; j < 4; ++j)
#pragma unroll
            for (int e = 0; e < 4; ++e) { const LAS float* wp = wf + (4 * lane + 256 * j + e) * 8; wfa[j][e] = *(const LAS f32x4*)wp; wfb[j][e] = *(const LAS f32x4*)(wp + 4); }
        f32x4 nv[4];
        if (gw < MROWS) { const float* xr = (gw < SEQ) ? x_prompt + (size_t)gw * DM : x_sample + (size_t)(gw - SEQ) * DM;
#pragma unroll
            for (int j = 0; j < 4; ++j) nv[j] = *(const f32x4*)(xr + 4 * lane + 256 * j); }
        for (int m = gw; m < MROWS; m += NGW) {
            f32x4 v[4]; float ss = 0.f;
#pragma unroll
            for (int j = 0; j < 4; ++j) { v[j] = nv[j]; ss += (v[j][0] * v[j][0] + v[j][1] * v[j][1]) + (v[j][2] * v[j][2] + v[j][3] * v[j][3]); }
            { const int m2 = m + NGW;
              if (m2 < MROWS) { const float* xr = (m2 < SEQ) ? x_prompt + (size_t)m2 * DM : x_sample + (size_t)(m2 - SEQ) * DM;
#pragma unroll
                  for (int j = 0; j < 4; ++j) nv[j] = *(const f32x4*)(xr + 4 * lane + 256 * j); } }
            const float rstd = rsqrtf(wave_sum(ss) * (1.0f / DM) + EPS);
            float fl[8];
#pragma unroll
            for (int hh = 0; hh < 8; ++hh) fl[hh] = 0.f;
#pragma unroll
            for (int j = 0; j < 4; ++j) {
                const f32x4 gm = *(const f32x4*)(norm_mix + 4 * lane + 256 * j);
                v[j] = v[j] * rstd * gm;
                u32x2 w; w.x = cvtpk(v[j][0], v[j][1]); w.y = cvtpk(v[j][2], v[j][3]);
                *(u32x2*)(XN + (size_t)m * DM + 4 * lane + 256 * j) = w;
#pragma unroll
                for (int e = 0; e < 4; ++e) {
                    const f32x4 wa = wfa[j][e], wb = wfb[j][e];
                    fl[0] += v[j][e] * wa[0]; fl[1] += v[j][e] * wa[1]; fl[2] += v[j][e] * wa[2]; fl[3] += v[j][e] * wa[3];
                    fl[4] += v[j][e] * wb[0]; fl[5] += v[j][e] * wb[1]; fl[6] += v[j][e] * wb[2]; fl[7] += v[j][e] * wb[3];
                }
            }
            float mine = 0.f;
#pragma unroll
            for (int hh = 0; hh < 8; ++hh) { const float t = wave_sum(fl[hh]); if (lane == hh) mine = t; }
            if (lane < 8) {
                const float z = mine + b_forget[lane];
                const float lf = fminf(z, 0.f) - log1pf(expf(-fabsf(z)));
                if (m < SEQ) out[O_LFP + (size_t)m * 8 + lane] = lf; else out[O_LFS + (size_t)(m - SEQ) * 8 + lane] = lf;
            }
        }
        __syncthreads();
    }
    SEAM(0);

    if (IN(1)) {
        pg8::Gemm g{XN, W1t, MROWS, 4096, 1024, nullptr, nullptr}; pg8::StaticOrder S; S.init(MROWS, 4096, G, bx, 1024);
        Epi1 E{Pf, Qb, Kb, Vt, Gt, b_gate, out, (unsigned*)hnQ, (unsigned*)hnK};
        pg8::gemm_phase<Epi1, pg8::StaticOrder, true, true>(lds, g, S, E);
        {
            const int rem = 1088 % G; const bool helper = (rem == 0) || (bx >= rem);
            if (helper) {
                const int nh = (rem == 0) ? G : G - rem, hidx = (rem == 0) ? bx : bx - rem;
                for (int tile = hidx; tile < 256; tile += nh) {
                    float inc = out[O_LFP + (size_t)(64 * tile + lane) * 8 + wave] * LOG2E;
        #pragma unroll
                    for (int o = 1; o < 64; o <<= 1) { const float t = __shfl_up(inc, o); if (lane >= o) inc += t; }
                    LH2[(size_t)wave * SEQ + 64 * tile + lane] = inc;
                    { const unsigned hb = cvtpk(inc, 0.f) & 0xffffu; const float hf = __uint_as_float(hb << 16); const unsigned lb = cvtpk(inc - hf, 0.f) & 0xffffu;
                      KX[(size_t)wave * SEQ + 64 * tile + lane] = (u32x4){hb | (lb << 16), 0u, 0u, 0u}; }
                    if (lane == 63) TT2[tile * 8 + wave] = inc;
                }
                LAS float* scr = (LAS float*)(lds + wave * 8704);
                constexpr int I2 = 8 * 32, I3 = 8 * 32, I4 = 16 * 32, I5 = 16 * 88, I6 = 16 * 88, I7 = 44 * 32;
                for (int it = hidx * 8 + wave; it < I2 + I3 + I4 + I5 + I6 + I7; it += nh * 8) {
                    int r = it;
                    if (r < I2) { const int kb = r / 32, nb = r % 32; tr_item(w_branch_pool, 1024, 512, Wbp, 32 * nb, 64 * kb, 32 * nb, scr, lane); continue; } r -= I2;
                    if (r < I3) { const int kb = r / 32, nb = r % 32; tr_item(w_branch_attn, 1024, 512, Wba, 32 * nb, 64 * kb, 32 * nb, scr, lane); continue; } r -= I3;
                    if (r < I4) { const int kb = r / 32, nb = r % 32; tr_item(w_out, 1024, 1024, Wo, 32 * nb, 64 * kb, 32 * nb, scr, lane); continue; } r -= I4;
                    if (r < I5) { const int kb = r / 88, nb = r % 88, n0 = 32 * nb; tr_item(w_ffn_gate, DFF, 1024, Wgu, 256 * (n0 >> 7) + (n0 & 127), 64 * kb, n0, scr, lane); continue; } r -= I5;
                    if (r < I6) { const int kb = r / 88, nb = r % 88, n0 = 32 * nb; tr_item(w_ffn_up, DFF, 1024, Wgu, 256 * (n0 >> 7) + 128 + (n0 & 127), 64 * kb, n0, scr, lane); continue; } r -= I6;
                    { const int kb = r / 32, nb = r % 32; tr_item(w_ffn_down, 1024, DFF, Wd, 32 * nb, 64 * kb, 32 * nb, scr, lane); }
                }
            }
        }
    }
    SEAM(1);

    if (IN(2)) {
        LAS float* wsf = (LAS float*)(lds + 69632) + wave * 256;
        LAS unsigned* sitem = (LAS unsigned*)(lds + 69632 + 8 * 1024);
        for (int i3 = bx; i3 < 544; i3 += G) pool_item(i3 >> 2, i3 & 3, Pf, state_pool, Wpg, pool_scale, OP, lds, tid);
        LAS float* offs = (LAS float*)(lds + 80000);
        for (;;) {
            if (tid == 0) sitem[0] = atomicAdd(ctr, 1u);
            __syncthreads();
            const int item = (int)sitem[0];
            __syncthreads();
            if (item >= 768) break;
            const int tri = item / 3, rm = item - 3 * tri;
            if (rm == 0) attn_sample_block(tri >> 3, tri & 7, Qb, cache_k, cache_v, cache_logf, out, OA, lds, wsf, wave, lane, tid);
            else { const int i2 = 2 * tri + rm - 1, h = i2 & 7, qb256 = 63 - (i2 >> 3);
                   attn_prompt_block(qb256, h, Qb, Kb, Vt, KX, LH2, TT2, hnQ, hnK, OA, lds, wsf, offs, wave, lane); }
        }
    }
    SEAM(2);

    if (IN(3)) {
        { pg8::Gemm g{OP, Wbp, MROWS, 1024, 512, OA, Wba}; Order3a S; S.init(G, bx); Epi3<0> E{Tf, Gt, MG, PA}; pg8::gemm_phase<Epi3<0>, Order3a, true, true>(lds, g, S, E); }
        { pg8::Gemm g{OA, Wba, SEQ, 1024, 512, nullptr, nullptr}; pg8::StaticOrder S; S.init(SEQ, 1024, G, bx, 512); Epi3<1> E{Tf, Gt, MG, PA}; pg8::gemm_phase<Epi3<1>, pg8::StaticOrder, true, true>(lds, g, S, E); }
    }
    SEAM(3);

    if (IN(4)) {
        const int hb = G - 1 - bx, hgw = hb * 8 + wave;
        if (hgw < NSAMP) {
            const int r = hgw; const bf16_t* grow = Gt + (size_t)(SEQ + r) * 2048;
#pragma unroll
            for (int j = 0; j < 4; ++j) {
                const int c = 4 * lane + 256 * j;
                const f32x4 a = *(const f32x4*)(PA + (size_t)r * 1024 + c) + *(const f32x4*)(PA + (size_t)(NSAMP + r) * 1024 + c);
                const f32x4 bq = *(const f32x4*)(PA + (size_t)(2 * NSAMP + r) * 1024 + c) + *(const f32x4*)(PA + (size_t)(3 * NSAMP + r) * 1024 + c);
                const u32x2 ga = *(const u32x2*)(grow + c), gb = *(const u32x2*)(grow + 1024 + c);
                const float m0 = a[0] * __uint_as_float(ga.x << 16) + bq[0] * __uint_as_float(gb.x << 16), m1 = a[1] * __uint_as_float(ga.x & 0xffff0000u) + bq[1] * __uint_as_float(gb.x & 0xffff0000u);
                const float m2 = a[2] * __uint_as_float(ga.y << 16) + bq[2] * __uint_as_float(gb.y << 16), m3 = a[3] * __uint_as_float(ga.y & 0xffff0000u) + bq[3] * __uint_as_float(gb.y & 0xffff0000u);
                u32x2 w; w.x = cvtpk(m0, m1); w.y = cvtpk(m2, m3);
                st_wt64(MG + (size_t)(SEQ + r) * 1024 + c, w.x, w.y);
            }
        }
        if (hb * 8 < NSAMP) {
            asm volatile("s_waitcnt vmcnt(0)" ::: "memory"); __syncthreads();
            if (tid == 0) __hip_atomic_fetch_add(flag3, 8u, __ATOMIC_RELAXED, __HIP_MEMORY_SCOPE_AGENT);
        }
        pg8::Gemm g{MG, Wo, MROWS, 1024, 1024, nullptr, nullptr}; Order4 S; S.init(G, bx, flag3);
        Epi4 E{x_prompt, x_sample, out + O_Y, HN, norm_ffn, rss1, PB};
        pg8::gemm_phase<Epi4, Order4, true, true>(lds, g, S, E);
    }
    SEAM(4);

    if (IN(5)) {
        const int rem5 = 1496 % G; const bool fin = (rem5 == 0) || (bx >= rem5);
        const int nh5 = (rem5 == 0) ? G : G - rem5, hidx5 = (rem5 == 0) ? bx : bx - rem5;
        if (fin) for (int r = hidx5 * 8 + wave; r < NSAMP; r += nh5 * 8) {
            float ss = 0.f;
#pragma unroll
            for (int j = 0; j < 4; ++j) {
                const int c = 4 * lane + 256 * j;
                f32x4 v = *(const f32x4*)(x_sample + (size_t)r * 1024 + c);
#pragma unroll
                for (int ch = 0; ch < 4; ++ch) v = v + *(const f32x4*)(PB + (size_t)(ch * NSAMP + r) * 1024 + c);
                *(f32x4*)(out + O_Y + (size_t)(SEQ + r) * 1024 + c) = v;
                const f32x4 nw = *(const f32x4*)(norm_ffn + c);
                u32x2 w; w.x = cvtpk(v[0] * nw[0], v[1] * nw[1]); w.y = cvtpk(v[2] * nw[2], v[3] * nw[3]);
                st_wt64(HN + (size_t)(SEQ + r) * 1024 + c, w.x, w.y);
                ss += (v[0] * v[0] + v[1] * v[1]) + (v[2] * v[2] + v[3] * v[3]);
            }
            ss = wave_sum(ss);
            if (lane == 0) __hip_atomic_store((unsigned*)(rss1 + SEQ + r), __float_as_uint(ss), __ATOMIC_RELAXED, __HIP_MEMORY_SCOPE_AGENT);
        }
        if (fin && hidx5 < NSAMP / 8) {
            asm volatile("s_waitcnt vmcnt(0)" ::: "memory"); __syncthreads();
            if (tid == 0) __hip_atomic_fetch_add(flag4, 8u * (unsigned)((NSAMP / 8 - hidx5 + nh5 - 1) / nh5), __ATOMIC_RELAXED, __HIP_MEMORY_SCOPE_AGENT);
        }
        pg8::Gemm g{HN, Wgu, MROWS, 2 * DFF, 1024, nullptr, nullptr}; LAS float* lrs = (LAS float*)(lds + 131072 + 1024); Order5 S; S.init(G, bx, flag4, rss1, lrs);
        Epi5 E{HF, lrs, 0};
        pg8::gemm_phase<Epi5, Order5, true, true>(lds, g, S, E);
    }
    SEAM(5);

    if (IN(6)) {
        pg8::Gemm g{HF, Wd, MROWS, 1024, DFF, nullptr, nullptr}; Order6 S; S.init(G, bx);
        Epi6 E{out + O_Y, PART, X2b};
        pg8::gemm_phase<Epi6, Order6, true, true>(lds, g, S, E);
    }
    SEAM(6);

    if (IN(7)) {
        for (int m = gw; m < MROWS; m += NGW) {
            float* y = out + O_Y + (size_t)m * DM;
            f32x4 v[4]; float ss = 0.f;
            if (m < SEQ) {
#pragma unroll
                for (int j = 0; j < 4; ++j) { const u32x2 w = *(const u32x2*)(X2b + (size_t)m * DM + 4 * lane + 256 * j);
                    v[j] = (f32x4){__uint_as_float(w.x << 16), __uint_as_float(w.x & 0xffff0000u), __uint_as_float(w.y << 16), __uint_as_float(w.y & 0xffff0000u)}; }
            } else {
#pragma unroll
                for (int j = 0; j < 4; ++j) v[j] = *(const f32x4*)(y + 4 * lane + 256 * j);
            }
            if (m >= SEQ) {
                for (int ch = 0; ch < 11; ++ch) {
                    const float* pp = PART + (size_t)ch * (NSAMP * 1024) + (size_t)(m - SEQ) * 1024;
#pragma unroll
                    for (int j = 0; j < 4; ++j) v[j] = v[j] + *(const f32x4*)(pp + 4 * lane + 256 * j);
                }
            }
#pragma unroll
            for (int j = 0; j < 4; ++j) ss += (v[j][0] * v[j][0] + v[j][1] * v[j][1]) + (v[j][2] * v[j][2] + v[j][3] * v[j][3]);
            const float rstd = rsqrtf(wave_sum(ss) * (1.0f / DM) + EPS);
#pragma unroll
            for (int j = 0; j < 4; ++j) {
                const f32x4 gm = *(const f32x4*)(norm_final + 4 * lane + 256 * j);
                __builtin_nontemporal_store(v[j] * rstd * gm, (f32x4*)(y + 4 * lane + 256 * j));
            }
        }
    }
    if (p.ph_hi - p.ph_lo > 1 && bx == 0 && tid == 0) __hip_atomic_store(startw, 0u, __ATOMIC_RELAXED, __HIP_MEMORY_SCOPE_AGENT);
#undef IN
#undef SEAM
}

#ifndef N_LAUNCHES
#define N_LAUNCHES 1
#endif

extern "C" void kernel_launch(void* const* d_in, const int* in_sizes, int n_in, void* d_out, int out_size, void* d_ws, size_t ws_size, hipStream_t stream) {
    static int grid = 0;
    if (grid == 0) {
        int dev = 0, cus = 0, per_cu = 0;
        hipGetDevice(&dev);
        hipDeviceGetAttribute(&cus, hipDeviceAttributeMultiprocessorCount, dev);
        hipFuncSetAttribute((const void*)fwd_kernel, hipFuncAttributeMaxDynamicSharedMemorySize, LDS_BYTES);
        hipOccupancyMaxActiveBlocksPerMultiprocessor(&per_cu, (const void*)fwd_kernel, NTHREADS, LDS_BYTES);
        if (per_cu < 1) per_cu = 1;
        grid = cus * per_cu;
        (void)hipGetLastError();
    }
    Params p{};
    for (int i = 0; i < 20; ++i) p.in[i] = (const float*)d_in[i];
    p.out = (float*)d_out; p.ws = (unsigned char*)d_ws;
#if N_LAUNCHES == 1
    p.ph_lo = 0; p.ph_hi = 8;
    void* args[] = {&p};
    hipError_t e = hipLaunchCooperativeKernel((const void*)fwd_kernel, dim3(grid), dim3(NTHREADS), args, LDS_BYTES, stream);
    if (e != hipSuccess) fprintf(stderr, "cooperative launch failed: %s (grid %d)\n", hipGetErrorString(e), grid);
#else
    for (int k = 0; k < 8; ++k) {
        p.ph_lo = k; p.ph_hi = k + 1;
        hipLaunchKernelGGL(fwd_kernel, dim3(grid), dim3(NTHREADS), LDS_BYTES, stream, p);
    }
#endif
}
```

```cpp
#include <hip/hip_runtime.h>
#include <hip/hip_cooperative_groups.h>
#include <cstdio>
#include <cstdint>
namespace cg = cooperative_groups;

#define LAS __attribute__((address_space(3)))
typedef unsigned short bf16_t;
typedef short bf16x8 __attribute__((ext_vector_type(8)));
typedef float f32x4 __attribute__((ext_vector_type(4)));
typedef float f32x2 __attribute__((ext_vector_type(2)));
typedef float f32x16 __attribute__((ext_vector_type(16)));
typedef unsigned u32x4 __attribute__((ext_vector_type(4)));
typedef unsigned u32x2 __attribute__((ext_vector_type(2)));
typedef __bf16 bf16x2_t __attribute__((ext_vector_type(2)));

constexpr int DM = 1024, SEQ = 16384, NSAMP = 1024, MROWS = SEQ + NSAMP;
constexpr int PAST = 1024, NH = 8, DIN = 4104, DFF = 2816;
constexpr float EPS = 1e-6f, LOG2E = 1.4426950408889634f, C2 = 0.125f * 1.4426950408889634f;
constexpr size_t O_Y = 0, O_KP = 17825792, O_VP = 26214400, O_LFP = 34603008, O_POOLP = 34734080, O_KS = 34741760, O_VS = 35266048,
                 O_LFS = 35790336, O_POOLS = 35798528;
constexpr size_t MiB = 1u << 20;
constexpr size_t WS_CTL = 0;
constexpr size_t CTL_HNQ = 0, CTL_HNK = 16384, CTL_RSS1 = 32768, CTL_RSS2 = 32768 + 81920, CTL_CTR = 32768 + 2 * 81920, CTL_ZERO_END = CTL_CTR + 256;
constexpr size_t WS_BAR = 208 * 1024;
constexpr size_t WS_TT = 256 * 1024;
constexpr size_t WS_LH = 384 * 1024;
constexpr size_t WS_W1 = 1 * MiB;
constexpr size_t WS_WBP = 9 * MiB, WS_WBA = 10 * MiB, WS_WO = 11 * MiB;
constexpr size_t WS_WGU = 13 * MiB;
constexpr size_t WS_WD = 24 * MiB;
constexpr size_t WS_WPG = 30 * MiB;
constexpr size_t WS_XN = 32 * MiB;
constexpr size_t WS_G = 66 * MiB;
constexpr size_t WS_P = 134 * MiB;
constexpr size_t WS_Q = 168 * MiB, WS_K = 185 * MiB, WS_V = 201 * MiB;
constexpr size_t WS_OP = 217 * MiB, WS_OA = 234 * MiB;
constexpr size_t WS_T = 134 * MiB;
constexpr size_t WS_KX = 251 * MiB;
constexpr size_t WS_HF = 100 * MiB;

__device__ __forceinline__ unsigned cvtpk(float lo, float hi) { f32x2 v = {lo, hi}; bf16x2_t b = __builtin_convertvector(v, bf16x2_t); return __builtin_bit_cast(unsigned, b); }
__device__ __forceinline__ unsigned short cvt1(float x) { return (unsigned short)(cvtpk(x, 0.f) & 0xffffu); }
__device__ __forceinline__ float bf2f(unsigned short b) { return __uint_as_float(((unsigned)b) << 16); }
__device__ __forceinline__ int crow(int r, int hi) { return (r & 3) + 8 * (r >> 2) + 4 * hi; }
__device__ __forceinline__ float wave_sum(float v) {
#pragma unroll
    for (int o = 1; o < 64; o <<= 1) v += __shfl_xor(v, o);
    return v;
}
__device__ __forceinline__ float wave_max(float v) {
#pragma unroll
    for (int o = 1; o < 64; o <<= 1) v = fmaxf(v, __shfl_xor(v, o));
    return v;
}

namespace pg8 {
constexpr int BM = 256, BK = 64, HALF = 128, HTB = HALF * BK * 2, STAGE_BYTES = 8 * HTB, NXCD = 8, WGM = 4;
__host__ __device__ __forceinline__ int lds_byte(int r, int c) { const int st = (r >> 4) * 2 + (c >> 5), rr = r & 15, cc = c & 31, ob = rr * 64 + cc * 2; return st * 1024 + (ob ^ (((ob >> 9) & 1) << 5)); }
__host__ __device__ __forceinline__ void stage_rc(int b, int& R, int& C) { const int st = b / 1024, sb = b % 1024, swz = sb ^ (((sb >> 9) & 1) << 5); R = (st >> 1) * 16 + swz / 64; C = (st & 1) * 32 + (swz % 64) / 2; }
__host__ __device__ __forceinline__ int perm32(int rho) { const int n = rho >> 4, i = rho & 15; return 8 * (i >> 2) + 4 * n + (i & 3); }
struct Unit { int pm, pn, k0, nk, sel; };
struct Gemm { const bf16_t* A; const bf16_t* Bt; int M, N, K; const bf16_t* A2; const bf16_t* B2; };
struct StaticOrder {
    int nM, nN, nwg, G, c, nkf;
    __host__ __device__ __forceinline__ void init(int M, int N, int G_, int c_, int K_) { nM = M / BM; nN = N / BM; nwg = nM * nN; G = G_; c = c_; nkf = K_ / BK; }
    __host__ __device__ __forceinline__ bool next(int i, Unit& u) const {
        const long L = (long)i * G + c; if (L >= nwg) return false;
        int wgid = (int)L; { const int q = nwg / NXCD, r = nwg % NXCD, xcd = wgid % NXCD, off = wgid / NXCD; wgid = (xcd < r ? xcd * (q + 1) : r * (q + 1) + (xcd - r) * q) + off; }
        const int nig = WGM * nN, gid = wgid / nig, fm = gid * WGM, gsz = (nM - fm) < WGM ? (nM - fm) : WGM;
        u.pm = fm + ((wgid % nig) % gsz); u.pn = (wgid % nig) / gsz; u.k0 = 0; u.nk = nkf; u.sel = 0; return true;
    }
    __device__ __forceinline__ void a_ready(const Unit&) const {}
    __device__ __forceinline__ void done(const Unit&) const {}
};

template <class Epi, class Sched, bool ALIGN_EPI = false, bool SP2 = false>
__device__ __forceinline__ void gemm_phase(LAS unsigned char* lds, const Gemm g, const Sched& S, const Epi& E) {
    const int tid = threadIdx.x, wid = __builtin_amdgcn_readfirstlane(tid >> 6), lane = tid & 63, wr = wid >> 2, wc = wid & 3, fr = lane & 15, fq = lane >> 4;
    const int K = g.K;
    unsigned voffA[2], voffB[2];
#pragma unroll
    for (int i = 0; i < 2; ++i) { int R, C; stage_rc(tid * 16 + i * 8192, R, C); const int Rb = Epi::PERM ? ((R & ~31) + perm32(R & 31)) : R;
        voffA[i] = (unsigned)(R * K + C) * 2u; voffB[i] = (unsigned)(Rb * K + C) * 2u; }
    const size_t kstep = (size_t)(BK * 2);
    const size_t hstep = (size_t)HALF * K * 2;
    const size_t tstep = 2 * hstep;
    const unsigned ldsw = (unsigned)wid * 1024u;
    const int aoff = lds_byte(wr * 64 + fr, fq * 8), boff = lds_byte(wc * 32 + fr, fq * 8);
#define PG8_SA(b, h) (((b) * 2 + (h)) * HTB)
#define PG8_SB(b, h) ((4 + (b) * 2 + (h)) * HTB)
#define PG8_STAGE(bufoff, gbase, voff) do { _Pragma("unroll") for (int _i = 0; _i < 2; ++_i) \
        __builtin_amdgcn_global_load_lds((const unsigned*)((const char*)(gbase) + (voff)[_i]), (LAS unsigned*)(lds + (bufoff) + ldsw + _i * 8192), 16, 0, 0); } while (0)
#define PG8_LDA(dst, b, h) do { _Pragma("unroll") for (int m = 0; m < 4; ++m) _Pragma("unroll") for (int k = 0; k < 2; ++k) dst[m][k] = *(const LAS bf16x8*)(lds + PG8_SA(b, h) + aoff + m * 2048 + k * 1024); } while (0)
#define PG8_LDB(dst, b, h) do { _Pragma("unroll") for (int n = 0; n < 2; ++n) _Pragma("unroll") for (int k = 0; k < 2; ++k) dst[n][k] = *(const LAS bf16x8*)(lds + PG8_SB(b, h) + boff + n * 2048 + k * 1024); } while (0)
#define PG8_MMA(ai, bj, At, Bt) do { __builtin_amdgcn_s_setprio(1); _Pragma("unroll") for (int m = 0; m < 4; ++m) _Pragma("unroll") for (int n = 0; n < 2; ++n) _Pragma("unroll") for (int k = 0; k < 2; ++k) \
        acc[ai][bj][m][n] = __builtin_amdgcn_mfma_f32_16x16x32_bf16(Bt[n][k], At[m][k], acc[ai][bj][m][n], 0, 0, 0); __builtin_amdgcn_s_setprio(0); } while (0)
#define PG8_WAIT_V(n) asm volatile("s_waitcnt vmcnt(" #n ")" ::: "memory")
#define PG8_WAIT_L(n) asm volatile("s_waitcnt lgkmcnt(" #n ")" ::: "memory")
#define PG8_BAR __builtin_amdgcn_s_barrier()
#define PG8_SCHED __builtin_amdgcn_sched_barrier(0)
    Unit cur, nxt; int ui = 0;
    if (!S.next(0, cur)) return;
    f32x4 acc[2][2][4][2];
#pragma unroll
    for (int a = 0; a < 2; ++a)
#pragma unroll
        for (int b = 0; b < 2; ++b)
#pragma unroll
            for (int m = 0; m < 4; ++m)
#pragma unroll
                for (int n = 0; n < 2; ++n) acc[a][b][m][n] = (f32x4){0.f, 0.f, 0.f, 0.f};
    bf16x8 At[4][2], B0[2][2], B1[2][2];
    const char* cA = (const char*)(cur.sel ? g.A2 : g.A) + (size_t)cur.pm * tstep + (size_t)cur.k0 * kstep; const char* cB = (const char*)(cur.sel ? g.B2 : g.Bt) + (size_t)cur.pn * tstep + (size_t)cur.k0 * kstep;
    S.a_ready(cur);
    if constexpr (SP2) {
        PG8_STAGE(PG8_SB(0, 0), cB, voffB); PG8_STAGE(PG8_SB(0, 1), cB + hstep, voffB); PG8_STAGE(PG8_SA(0, 0), cA, voffA); PG8_STAGE(PG8_SA(0, 1), cA + hstep, voffA);
        if (wr == 1) PG8_BAR;
        PG8_WAIT_V(2); PG8_BAR;
        PG8_STAGE(PG8_SB(1, 0), cB + kstep, voffB); PG8_STAGE(PG8_SA(1, 0), cA + kstep, voffA); PG8_STAGE(PG8_SB(1, 1), cB + hstep + kstep, voffB);
        PG8_WAIT_V(6); PG8_BAR;
    } else {
        PG8_STAGE(PG8_SB(0, 0), cB, voffB); PG8_STAGE(PG8_SA(0, 0), cA, voffA); PG8_STAGE(PG8_SB(0, 1), cB + hstep, voffB); PG8_STAGE(PG8_SA(0, 1), cA + hstep, voffA);
        if (wr == 1) PG8_BAR;
        PG8_WAIT_V(4); PG8_BAR;
        PG8_STAGE(PG8_SB(1, 0), cB + kstep, voffB); PG8_STAGE(PG8_SA(1, 0), cA + kstep, voffA); PG8_STAGE(PG8_SB(1, 1), cB + hstep + kstep, voffB);
        PG8_WAIT_V(6); PG8_BAR;
    }
    for (;;) {
        const bool has_next = S.next(ui + 1, nxt);
        const char* nA = has_next ? (const char*)(nxt.sel ? g.A2 : g.A) + (size_t)nxt.pm * tstep + (size_t)nxt.k0 * kstep : cA; const char* nB = has_next ? (const char*)(nxt.sel ? g.B2 : g.Bt) + (size_t)nxt.pn * tstep + (size_t)nxt.k0 * kstep : cB;
        const int nt = cur.nk;
        for (int t = 0; t < nt; t += 2) {
            const bool last = (t == nt - 2);
            const char* a1 = cA + (size_t)(t + 1) * kstep;
            const char* a2 = last ? nA : cA + (size_t)(t + 2) * kstep; const char* b2 = last ? nB : cB + (size_t)(t + 2) * kstep;
            const char* a3 = a2 + kstep; const char* b3 = b2 + kstep;
            if (last && has_next) S.a_ready(nxt);
            if constexpr (SP2) {
            PG8_LDB(B0, 0, 0); PG8_LDB(B1, 0, 1); PG8_SCHED; PG8_LDA(At, 0, 0); PG8_STAGE(PG8_SA(1, 1), a1 + hstep, voffA);
            PG8_WAIT_V(8); PG8_WAIT_L(0); PG8_BAR; PG8_MMA(0, 0, At, B0); PG8_MMA(0, 1, At, B1); PG8_BAR; PG8_SCHED;
            PG8_LDA(At, 0, 1); PG8_STAGE(PG8_SB(0, 0), b2, voffB); PG8_STAGE(PG8_SB(0, 1), b2 + hstep, voffB); PG8_STAGE(PG8_SA(0, 0), a2, voffA);
            PG8_WAIT_V(8); PG8_WAIT_L(0); PG8_BAR; PG8_MMA(1, 0, At, B0); PG8_MMA(1, 1, At, B1); PG8_BAR; PG8_SCHED;
            PG8_LDB(B0, 1, 0); PG8_LDB(B1, 1, 1); PG8_SCHED; PG8_LDA(At, 1, 0); PG8_STAGE(PG8_SA(0, 1), a2 + hstep, voffA);
            PG8_WAIT_V(8); PG8_WAIT_L(0); PG8_BAR; PG8_MMA(0, 0, At, B0); PG8_MMA(0, 1, At, B1); PG8_BAR; PG8_SCHED;
            PG8_LDA(At, 1, 1); PG8_STAGE(PG8_SB(1, 0), b3, voffB); PG8_STAGE(PG8_SB(1, 1), b3 + hstep, voffB); PG8_STAGE(PG8_SA(1, 0), a3, voffA);
            PG8_WAIT_V(8); PG8_WAIT_L(0); PG8_BAR; PG8_MMA(1, 0, At, B0); PG8_MMA(1, 1, At, B1); PG8_BAR; PG8_SCHED;
            } else {
            PG8_LDB(B0, 0, 0); PG8_SCHED; PG8_LDA(At, 0, 0); PG8_STAGE(PG8_SA(1, 1), a1 + hstep, voffA);
            PG8_WAIT_L(8); PG8_BAR; PG8_WAIT_L(0); PG8_MMA(0, 0, At, B0); PG8_BAR; PG8_SCHED;
            PG8_LDB(B1, 0, 1); PG8_STAGE(PG8_SB(0, 0), b2, voffB);
            PG8_BAR; PG8_WAIT_L(0); PG8_MMA(0, 1, At, B1); PG8_BAR;
            PG8_LDA(At, 0, 1); PG8_STAGE(PG8_SA(0, 0), a2, voffA);
            PG8_BAR; PG8_WAIT_L(0); PG8_MMA(1, 0, At, B0); PG8_BAR; PG8_SCHED;
            PG8_STAGE(PG8_SB(0, 1), b2 + hstep, voffB);
            PG8_WAIT_V(6); PG8_BAR; PG8_MMA(1, 1, At, B1); PG8_BAR;
            PG8_LDB(B0, 1, 0); PG8_SCHED; PG8_LDA(At, 1, 0); PG8_STAGE(PG8_SA(0, 1), a2 + hstep, voffA);
            PG8_WAIT_L(8); PG8_BAR; PG8_WAIT_L(0); PG8_MMA(0, 0, At, B0); PG8_BAR; PG8_SCHED;
            PG8_LDB(B1, 1, 1); PG8_STAGE(PG8_SB(1, 0), b3, voffB);
            PG8_BAR; PG8_WAIT_L(0); PG8_MMA(0, 1, At, B1); PG8_BAR;
            PG8_LDA(At, 1, 1); PG8_STAGE(PG8_SA(1, 0), a3, voffA);
            PG8_BAR; PG8_WAIT_L(0); PG8_MMA(1, 0, At, B0); PG8_BAR; PG8_SCHED;
            PG8_STAGE(PG8_SB(1, 1), b3 + hstep, voffB);
            PG8_WAIT_V(6); PG8_BAR; PG8_MMA(1, 1, At, B1); PG8_BAR;
            }
        }
        if constexpr (ALIGN_EPI) { if (wr == 0) PG8_BAR; }
        E(acc, cur, wr, wc, fr, fq); S.done(cur);
        if (!has_next) break;
#pragma unroll
        for (int a = 0; a < 2; ++a)
#pragma unroll
            for (int b = 0; b < 2; ++b)
#pragma unroll
                for (int m = 0; m < 4; ++m)
#pragma unroll
                    for (int n = 0; n < 2; ++n) acc[a][b][m][n] = (f32x4){0.f, 0.f, 0.f, 0.f};
        cur = nxt; cA = nA; cB = nB; ++ui;
        if constexpr (ALIGN_EPI) { if (wr == 1) PG8_BAR; }
    }
    PG8_WAIT_V(0);
    if constexpr (!ALIGN_EPI) { if (wr == 0) PG8_BAR; }
    PG8_BAR;
#undef PG8_SA
#undef PG8_SB
#undef PG8_STAGE
#undef PG8_LDA
#undef PG8_LDB
#undef PG8_MMA
#undef PG8_WAIT_V
#undef PG8_WAIT_L
#undef PG8_BAR
#undef PG8_SCHED
}
}

typedef const f32x4 (&AccRef)[2][2][4][2];
__device__ __forceinline__ u32x4 pack8(f32x4 a, f32x4 b) { u32x4 w; w.x = cvtpk(a[0], a[1]); w.y = cvtpk(a[2], a[3]); w.z = cvtpk(b[0], b[1]); w.w = cvtpk(b[2], b[3]); return w; }
__device__ __forceinline__ float sigm(float x) { return __builtin_amdgcn_rcpf(1.0f + __builtin_amdgcn_exp2f(-1.4426950408889634f * x)); }
__device__ __forceinline__ void unpack8(u32x4 w, float* g) {
    g[0] = __uint_as_float(w.x << 16); g[1] = __uint_as_float(w.x & 0xffff0000u); g[2] = __uint_as_float(w.y << 16); g[3] = __uint_as_float(w.y & 0xffff0000u);
    g[4] = __uint_as_float(w.z << 16); g[5] = __uint_as_float(w.z & 0xffff0000u); g[6] = __uint_as_float(w.w << 16); g[7] = __uint_as_float(w.w & 0xffff0000u);
}

struct Epi1 {
    static constexpr bool PERM = true, AFTER_DRAIN = false;
    float* P; bf16_t* Qb; bf16_t* Kb; bf16_t* Vt; bf16_t* G; const float* b_gate; float* out; unsigned* hnQ; unsigned* hnK;
    __device__ __forceinline__ void operator()(AccRef acc, const pg8::Unit& u, int wr, int wc, int fr, int fq) const {
        const int kind = u.pn; const bool prompt = u.pm < 64;
        const int cb = wc * 32 + 8 * fq;
        if (kind < 2) {
#pragma unroll
            for (int ai = 0; ai < 2; ++ai)
#pragma unroll
                for (int m = 0; m < 4; ++m) {
                    const int row = u.pm * 256 + ai * 128 + wr * 64 + m * 16 + fr;
                    float* po = nullptr;
                    if (prompt) { if (row >= SEQ - 15) po = out + O_POOLP + (size_t)(row - (SEQ - 15)) * 512; }
                    else { const int rs = row - SEQ, t = rs & 31; if (t >= 17) po = out + O_POOLS + (size_t)((rs >> 5) * 15 + t - 17) * 512; }
#pragma unroll
                    for (int bj = 0; bj < 2; ++bj) {
                        const int lc = kind * 256 + bj * 128 + cb;
                        float* dst = P + (size_t)row * 512 + lc;
                        *(f32x4*)dst = acc[ai][bj][m][0]; *(f32x4*)(dst + 4) = acc[ai][bj][m][1];
                        if (po) { *(f32x4*)(po + lc) = acc[ai][bj][m][0]; *(f32x4*)(po + lc + 4) = acc[ai][bj][m][1]; }
                    }
                }
        } else if (kind < 6) {
            const bool isq = kind < 4;
            const int base = isq ? 512 : 1024;
            const float sc = isq ? C2 : 1.0f;
            float* fo = prompt ? out + O_KP : out + O_KS - (size_t)SEQ * 512;
#pragma unroll
            for (int ai = 0; ai < 2; ++ai)
#pragma unroll
                for (int bj = 0; bj < 2; ++bj) {
                    const int lc = kind * 256 - base + bj * 128 + cb;
                    float mx = 0.f;
#pragma unroll
                    for (int m = 0; m < 4; ++m) {
                        const int row = u.pm * 256 + ai * 128 + wr * 64 + m * 16 + fr;
                        const f32x4 v0 = acc[ai][bj][m][0] * sc, v1 = acc[ai][bj][m][1] * sc;
                        if (isq) { *(u32x4*)(Qb + (size_t)row * 512 + lc) = pack8(v0, v1); }
                        else {
                            float* d = fo + (size_t)row * 512 + lc; __builtin_nontemporal_store(v0, (f32x4*)d); __builtin_nontemporal_store(v1, (f32x4*)(d + 4));
                            if (prompt) *(u32x4*)(Kb + (size_t)row * 512 + lc) = pack8(v0, v1);
                        }
                        float s = (v0[0] * v0[0] + v0[1] * v0[1]) + (v0[2] * v0[2] + v0[3] * v0[3]) + (v1[0] * v1[0] + v1[1] * v1[1]) + (v1[2] * v1[2] + v1[3] * v1[3]);
                        s += __shfl_xor(s, 16); s += __shfl_xor(s, 32);
                        mx = fmaxf(mx, s);
                    }
                    if (prompt) {
                        mx = fmaxf(mx, __shfl_xor(mx, 1)); mx = fmaxf(mx, __shfl_xor(mx, 2)); mx = fmaxf(mx, __shfl_xor(mx, 4)); mx = fmaxf(mx, __shfl_xor(mx, 8));
                        const int colbase = kind * 256 - base + bj * 128 + wc * 32;
                        if (fr == 0 && fq == 0) atomicMax((isq ? hnQ : hnK) + ((2 * u.pm + ai) * 8 + (colbase >> 6)) * 2 + ((colbase >> 5) & 1), __float_as_uint(mx));
                    }
                }
        } else if (kind < 8) {
            float* fo = prompt ? out + O_VP : out + O_VS - (size_t)SEQ * 512;
#pragma unroll
            for (int ai = 0; ai < 2; ++ai)
#pragma unroll
                for (int m = 0; m < 4; ++m) {
                    const int row = u.pm * 256 + ai * 128 + wr * 64 + m * 16 + fr;
                    const int o16 = row & 15, kvp = (row & 48) + 8 * ((o16 >> 2) & 1) + (o16 & 3) + 4 * (o16 >> 3);
#pragma unroll
                    for (int bj = 0; bj < 2; ++bj) {
                        const int lc = kind * 256 - 1536 + bj * 128 + cb;
                        const f32x4 v0 = acc[ai][bj][m][0], v1 = acc[ai][bj][m][1];
                        float* d = fo + (size_t)row * 512 + lc; __builtin_nontemporal_store(v0, (f32x4*)d); __builtin_nontemporal_store(v1, (f32x4*)(d + 4));
                        if (prompt) {
                            bf16_t* vt = Vt + ((size_t)((lc >> 6) * 256 + (row >> 6)) * 64 + (lc & 63)) * 64 + kvp;
                            vt[0] = cvt1(v0[0]); vt[64] = cvt1(v0[1]); vt[128] = cvt1(v0[2]); vt[192] = cvt1(v0[3]);
                            vt[256] = cvt1(v1[0]); vt[320] = cvt1(v1[1]); vt[384] = cvt1(v1[2]); vt[448] = cvt1(v1[3]);
                        }
                    }
                }
        } else {
#pragma unroll
            for (int bj = 0; bj < 2; ++bj) {
                const int lc = kind * 256 - 2048 + bj * 128 + cb;
                const f32x4 b0 = *(const f32x4*)(b_gate + lc), b1 = *(const f32x4*)(b_gate + lc + 4);
#pragma unroll
                for (int ai = 0; ai < 2; ++ai)
#pragma unroll
                    for (int m = 0; m < 4; ++m) {
                        const int row = u.pm * 256 + ai * 128 + wr * 64 + m * 16 + fr;
                        f32x4 v0 = acc[ai][bj][m][0] + b0, v1 = acc[ai][bj][m][1] + b1;
#pragma unroll
                        for (int e = 0; e < 4; ++e) { v0[e] = sigm(v0[e]); v1[e] = sigm(v1[e]); }
                        *(u32x4*)(G + (size_t)row * 2048 + lc) = pack8(v0, v1);
                    }
            }
        }
    }
};

__device__ __forceinline__ void st_wt64(void* p, unsigned lo, unsigned hi) {
    __hip_atomic_store((unsigned long long*)p, ((unsigned long long)hi << 32) | lo, __ATOMIC_RELAXED, __HIP_MEMORY_SCOPE_AGENT);
}
__device__ __forceinline__ void wait_flag(const unsigned* flag, unsigned want) {
    while (__hip_atomic_load(flag, __ATOMIC_RELAXED, __HIP_MEMORY_SCOPE_AGENT) < want) __builtin_amdgcn_s_sleep(2);
    asm volatile("" ::: "memory");
}
struct Order3a {
    pg8::StaticOrder S0; int G, c;
    __device__ __forceinline__ void init(int G_, int c_) { S0.init(SEQ, 1024, G_, c_, 512); G = G_; c = c_; }
    __device__ __forceinline__ bool next(int i, pg8::Unit& u) const {
        const long L = (long)i * G + c;
        if (L < 256) return S0.next(i, u);
        const int s = (int)L - 256; if (s >= 64) return false;
        const int r = s & 31, id = r >> 1;
        u.pm = 64 + (id >> 2); u.pn = id & 3; u.k0 = 4 * (r & 1); u.nk = 4; u.sel = s >> 5; return true;
    }
    __device__ __forceinline__ void a_ready(const pg8::Unit&) const {}
    __device__ __forceinline__ void done(const pg8::Unit&) const {}
};
template <int PASS> struct Epi3 {
    static constexpr bool PERM = true, AFTER_DRAIN = false;
    bf16_t* T; const bf16_t* G; bf16_t* MG; float* PA;
    __device__ __forceinline__ void operator()(AccRef acc, const pg8::Unit& u, int wr, int wc, int fr, int fq) const {
        const bool samp = (PASS == 0) && (u.pm >= 64);
        float* pa = PA + (size_t)(2 * u.sel + (u.k0 >> 2)) * (NSAMP * 1024) - (size_t)SEQ * 1024;
#pragma unroll
        for (int ai = 0; ai < 2; ++ai)
#pragma unroll
            for (int m = 0; m < 4; ++m) {
                const int row = u.pm * 256 + ai * 128 + wr * 64 + m * 16 + fr;
#pragma unroll
                for (int bj = 0; bj < 2; ++bj) {
                    const int col = u.pn * 256 + bj * 128 + wc * 32 + 8 * fq;
                    f32x4 v0 = acc[ai][bj][m][0], v1 = acc[ai][bj][m][1];
                    if (samp) { float* p = pa + (size_t)row * 1024 + col; *(f32x4*)p = v0; *(f32x4*)(p + 4) = v1; continue; }
                    float g[8]; unpack8(*(const u32x4*)(G + (size_t)row * 2048 + (PASS == 0 ? 0 : 1024) + col), g);
                    v0 = v0 * (f32x4){g[0], g[1], g[2], g[3]}; v1 = v1 * (f32x4){g[4], g[5], g[6], g[7]};
                    bf16_t* t = T + (size_t)row * 1024 + col;
                    if (PASS == 0) { *(u32x4*)t = pack8(v0, v1); }
                    else { float tv[8]; unpack8(*(const u32x4*)t, tv); v0 = v0 + (f32x4){tv[0], tv[1], tv[2], tv[3]}; v1 = v1 + (f32x4){tv[4], tv[5], tv[6], tv[7]}; *(u32x4*)(MG + (size_t)row * 1024 + col) = pack8(v0, v1); }
                }
            }
    }
};

struct Order4 {
    pg8::StaticOrder S0; int G, c; const unsigned* flag;
    __device__ __forceinline__ void init(int G_, int c_, const unsigned* f) { S0.init(SEQ, 1024, G_, c_, 1024); G = G_; c = c_; flag = f; }
    __device__ __forceinline__ bool next(int i, pg8::Unit& u) const {
        const long L = (long)i * G + c;
        if (L < 256) return S0.next(i, u);
        const int s = (int)L - 256; if (s >= 64) return false;
        const int id = s >> 2;
        u.pm = 64 + (id >> 2); u.pn = id & 3; u.k0 = 4 * (s & 3); u.nk = 4; u.sel = 0; return true;
    }
    __device__ __forceinline__ void a_ready(const pg8::Unit& u) const { if (u.pm >= 64) wait_flag(flag, NSAMP); }
    __device__ __forceinline__ void done(const pg8::Unit&) const {}
};
struct Order5 {
    pg8::StaticOrder S0; const unsigned* flag; const float* rss; LAS float* lr; mutable int nready;
    __device__ __forceinline__ void init(int G_, int c_, const unsigned* f, const float* rss_, LAS float* lr_) { S0.init(MROWS, 2 * DFF, G_, c_, 1024); flag = f; rss = rss_; lr = lr_; nready = 0; }
    __device__ __forceinline__ bool next(int i, pg8::Unit& u) const { return S0.next(i, u); }
    __device__ __forceinline__ void a_ready(const pg8::Unit& u) const {
        if (u.pm >= 64) wait_flag(flag, NSAMP);
        if (threadIdx.x < 256) lr[(nready & 1) * 256 + threadIdx.x] = rsqrtf(rss[u.pm * 256 + threadIdx.x] * (1.0f / 1024.0f) + EPS);
        ++nready;
    }
    __device__ __forceinline__ void done(const pg8::Unit&) const {}
};
struct Epi4 {
    static constexpr bool PERM = true, AFTER_DRAIN = false;
    const float* xp; const float* xs; float* Y; bf16_t* HN; const float* nw; float* rss; float* PB;
    __device__ __forceinline__ void operator()(AccRef acc, const pg8::Unit& u, int wr, int wc, int fr, int fq) const {
        if (u.pm >= 64) {
            float* pb = PB + (size_t)(u.k0 >> 2) * (NSAMP * 1024) - (size_t)SEQ * 1024;
#pragma unroll
            for (int ai = 0; ai < 2; ++ai)
#pragma unroll
                for (int m = 0; m < 4; ++m) {
                    const int row = u.pm * 256 + ai * 128 + wr * 64 + m * 16 + fr;
#pragma unroll
                    for (int bj = 0; bj < 2; ++bj) { float* p = pb + (size_t)row * 1024 + u.pn * 256 + bj * 128 + wc * 32 + 8 * fq; *(f32x4*)p = acc[ai][bj][m][0]; *(f32x4*)(p + 4) = acc[ai][bj][m][1]; }
                }
            return;
        }
        const float* xb = xp;
        f32x4 w[2][2];
#pragma unroll
        for (int bj = 0; bj < 2; ++bj) { const int col = u.pn * 256 + bj * 128 + wc * 32 + 8 * fq; w[bj][0] = *(const f32x4*)(nw + col); w[bj][1] = *(const f32x4*)(nw + col + 4); }
#pragma unroll
        for (int ai = 0; ai < 2; ++ai)
#pragma unroll
            for (int m = 0; m < 4; ++m) {
                const int row = u.pm * 256 + ai * 128 + wr * 64 + m * 16 + fr;
                float s = 0.f;
#pragma unroll
                for (int bj = 0; bj < 2; ++bj) {
                    const int col = u.pn * 256 + bj * 128 + wc * 32 + 8 * fq;
                    const float* xr = xb + (size_t)row * 1024 + col;
                    const f32x4 v0 = acc[ai][bj][m][0] + *(const f32x4*)xr, v1 = acc[ai][bj][m][1] + *(const f32x4*)(xr + 4);
                    float* y = Y + (size_t)row * 1024 + col; *(f32x4*)y = v0; *(f32x4*)(y + 4) = v1;
                    *(u32x4*)(HN + (size_t)row * 1024 + col) = pack8(v0 * w[bj][0], v1 * w[bj][1]);
                    s += (v0[0] * v0[0] + v0[1] * v0[1]) + (v0[2] * v0[2] + v0[3] * v0[3]) + (v1[0] * v1[0] + v1[1] * v1[1]) + (v1[2] * v1[2] + v1[3] * v1[3]);
                }
                s += __shfl_xor(s, 16); s += __shfl_xor(s, 32);
                if (fq == 0) atomicAdd(rss + row, s);
            }
    }
};

struct Epi5 {
    static constexpr bool PERM = true, AFTER_DRAIN = false;
    bf16_t* HF; const LAS float* lr; mutable int ndone;
    __device__ __forceinline__ void operator()(AccRef acc, const pg8::Unit& u, int wr, int wc, int fr, int fq) const {
        const int slot = (ndone & 1) * 256; ++ndone;
#pragma unroll
        for (int ai = 0; ai < 2; ++ai)
#pragma unroll
            for (int m = 0; m < 4; ++m) {
                const int row = u.pm * 256 + ai * 128 + wr * 64 + m * 16 + fr;
                const float rstd = lr[slot + ai * 128 + wr * 64 + m * 16 + fr];
                f32x4 h[2];
#pragma unroll
                for (int n = 0; n < 2; ++n) {
                    const f32x4 g = acc[ai][0][m][n] * rstd, up = acc[ai][1][m][n] * rstd;
#pragma unroll
                    for (int e = 0; e < 4; ++e) h[n][e] = g[e] * sigm(g[e]) * up[e];
                }
                *(u32x4*)(HF + (size_t)row * DFF + u.pn * 128 + wc * 32 + 8 * fq) = pack8(h[0], h[1]);
            }
    }
};

struct Order6 {
    pg8::StaticOrder S0; int G, c;
    __device__ __forceinline__ void init(int G_, int c_) { S0.init(SEQ, 1024, G_, c_, DFF); G = G_; c = c_; }
    __device__ __forceinline__ bool next(int i, pg8::Unit& u) const {
        const long L = (long)i * G + c;
        if (L < 256) return S0.next(i, u);
        const int s = (int)L - 256; if (s >= 176) return false;
        const int id = s / 11, ch = s - 11 * id;
        u.pm = 64 + (id >> 2); u.pn = id & 3; u.k0 = 4 * ch; u.nk = 4; u.sel = 0; return true;
    }
    __device__ __forceinline__ void a_ready(const pg8::Unit&) const {}
    __device__ __forceinline__ void done(const pg8::Unit&) const {}
};
struct Epi6 {
    static constexpr bool PERM = true, AFTER_DRAIN = false;
    float* Y; float* PART; bf16_t* X2b;
    __device__ __forceinline__ void operator()(AccRef acc, const pg8::Unit& u, int wr, int wc, int fr, int fq) const {
        const bool full = u.pm < 64;
        float* base = full ? Y : PART + (size_t)(u.k0 >> 2) * (NSAMP * 1024) - (size_t)SEQ * 1024;
#pragma unroll
        for (int ai = 0; ai < 2; ++ai)
#pragma unroll
            for (int m = 0; m < 4; ++m) {
                const int row = u.pm * 256 + ai * 128 + wr * 64 + m * 16 + fr;
#pragma unroll
                for (int bj = 0; bj < 2; ++bj) {
                    float* y = base + (size_t)row * 1024 + u.pn * 256 + bj * 128 + wc * 32 + 8 * fq;
                    f32x4 v0 = acc[ai][bj][m][0], v1 = acc[ai][bj][m][1];
                    if (full) { v0 = v0 + *(const f32x4*)y; v1 = v1 + *(const f32x4*)(y + 4); *(u32x4*)(X2b + (y - Y)) = pack8(v0, v1); }
                    else { *(f32x4*)y = v0; *(f32x4*)(y + 4) = v1; }
                }
            }
    }
};

#define MFMA32(a, b, c) __builtin_amdgcn_mfma_f32_32x32x16_bf16((a), (b), (c), 0, 0, 0)
struct AttnSt { float m, l; f32x16 o0, o1; };
__device__ __forceinline__ bf16x8 packp(const f32x16& p, int s) {
    u32x4 w; w.x = cvtpk(p[8 * s], p[8 * s + 1]); w.y = cvtpk(p[8 * s + 2], p[8 * s + 3]); w.z = cvtpk(p[8 * s + 4], p[8 * s + 5]); w.w = cvtpk(p[8 * s + 6], p[8 * s + 7]);
    return __builtin_bit_cast(bf16x8, w);
}
template <bool HALF>
__device__ __forceinline__ void attn_step(AttnSt& st, const bf16x8 (&qr)[4], const bf16x8 (&kf)[8], const bf16x8 (&vf)[8], f32x16 p0, f32x16 p1, LAS float* wsf, int ql, int hi) {
#pragma unroll
    for (int d0 = 0; d0 < 4; ++d0) { p0 = MFMA32(kf[d0], qr[d0], p0); if (!HALF) p1 = MFMA32(kf[4 + d0], qr[d0], p1); }
    float mx = p0[0];
#pragma unroll
    for (int r = 1; r < 16; ++r) mx = fmaxf(mx, p0[r]);
    if (!HALF) {
#pragma unroll
        for (int r = 0; r < 16; ++r) mx = fmaxf(mx, p1[r]);
    }
    mx = fmaxf(mx, __shfl_xor(mx, 32));
    if (__any(mx > st.m)) {
        const float mn = fmaxf(st.m, mx), al = __builtin_amdgcn_exp2f(st.m - mn);
        st.m = mn; st.l *= al;
        if (hi == 0) wsf[ql] = al;
        asm volatile("s_waitcnt lgkmcnt(0)" ::: "memory");
#pragma unroll
        for (int g = 0; g < 4; ++g) {
            const f32x4 a = *(const LAS f32x4*)(wsf + 8 * g + 4 * hi);
#pragma unroll
            for (int e = 0; e < 4; ++e) { st.o0[4 * g + e] *= a[e]; st.o1[4 * g + e] *= a[e]; }
        }
        asm volatile("s_waitcnt lgkmcnt(0)" ::: "memory");
    }
    float s = 0.f;
#pragma unroll
    for (int r = 0; r < 16; ++r) { p0[r] = __builtin_amdgcn_exp2f(p0[r] - st.m); s += p0[r]; }
    if (!HALF) {
#pragma unroll
        for (int r = 0; r < 16; ++r) { p1[r] = __builtin_amdgcn_exp2f(p1[r] - st.m); s += p1[r]; }
    }
    st.l += s;
    const bf16x8 a0 = packp(p0, 0), a1 = packp(p0, 1);
    st.o0 = MFMA32(a0, vf[0], st.o0); st.o1 = MFMA32(a0, vf[4], st.o1);
    st.o0 = MFMA32(a1, vf[1], st.o0); st.o1 = MFMA32(a1, vf[5], st.o1);
    if (!HALF) {
        const bf16x8 a2 = packp(p1, 0), a3 = packp(p1, 1);
        st.o0 = MFMA32(a2, vf[2], st.o0); st.o1 = MFMA32(a2, vf[6], st.o1);
        st.o0 = MFMA32(a3, vf[3], st.o0); st.o1 = MFMA32(a3, vf[7], st.o1);
    }
}
__device__ __forceinline__ void attn_finish(AttnSt& st, bf16_t* orow0, LAS float* wsf, int ql, int hi) {
    const float lt = st.l + __shfl_xor(st.l, 32);
    if (hi == 0) wsf[ql] = 1.0f / lt;
    asm volatile("s_waitcnt lgkmcnt(0)" ::: "memory");
#pragma unroll
    for (int g = 0; g < 4; ++g) {
        const f32x4 a = *(const LAS f32x4*)(wsf + 8 * g + 4 * hi);
#pragma unroll
        for (int e = 0; e < 4; ++e) {
            bf16_t* o = orow0 + (size_t)(8 * g + 4 * hi + e) * 512 + ql;
            o[0] = cvt1(st.o0[4 * g + e] * a[e]); o[32] = cvt1(st.o1[4 * g + e] * a[e]);
        }
    }
    asm volatile("s_waitcnt lgkmcnt(0)" ::: "memory");
}

__device__ __forceinline__ void attn_prompt_item(int q0, int h, const bf16_t* Qb, const bf16_t* Kb, const bf16_t* Vt, const float* LH2, const float* TT2,
                                                 const float* hnQ, const float* hnK, bf16_t* OA, LAS float* wsf, int lane) {
    const int ql = lane & 31, hi = lane >> 5;
    const int jd = q0 >> 6, qoff = q0 & 63;
    bf16x8 qr[4];
    { const bf16_t* qp = Qb + (size_t)(q0 + ql) * 512 + h * 64 + 8 * hi;
#pragma unroll
      for (int d0 = 0; d0 < 4; ++d0) qr[d0] = *(const bf16x8*)(qp + 16 * d0); }
    const float* lh = LH2 + (size_t)h * SEQ;
    const float cq = lh[q0 + ql];
    float nb;
    { const int t128 = q0 >> 7;
      const float qa = sqrtf(hnQ[(t128 * 8 + h) * 2]), qb = sqrtf(hnQ[(t128 * 8 + h) * 2 + 1]);
      const float kda = sqrtf(hnK[(t128 * 8 + h) * 2]), kdb = sqrtf(hnK[(t128 * 8 + h) * 2 + 1]);
      float ka = fmaxf(hnK[(lane * 8 + h) * 2], hnK[((lane + 64) * 8 + h) * 2]), kb = fmaxf(hnK[(lane * 8 + h) * 2 + 1], hnK[((lane + 64) * 8 + h) * 2 + 1]);
      ka = sqrtf(wave_max(ka)); kb = sqrtf(wave_max(kb));
      nb = 1.02f * (qa * (ka + kda) + qb * (kb + kdb)) + 2.0f; }
    const float l2q0 = __shfl(cq, 0);
    AttnSt st; st.m = -INFINITY; st.l = 0.f;
#pragma unroll
    for (int r = 0; r < 16; ++r) { st.o0[r] = 0.f; st.o1[r] = 0.f; }
    float sub = 0.f;
    for (int j = jd; j >= 0; --j) {
        const bool diag = (j == jd);
        if (!diag) {
            if (nb + l2q0 + sub < -152.f) break;
            sub += TT2[j * 8 + h];
        }
        bf16x8 kf[8], vf[8];
        const bf16_t* kb = Kb + (size_t)(64 * j + ql) * 512 + h * 64 + 8 * hi;
#pragma unroll
        for (int half = 0; half < 2; ++half)
#pragma unroll
            for (int d0 = 0; d0 < 4; ++d0) kf[half * 4 + d0] = *(const bf16x8*)(kb + (size_t)half * 32 * 512 + 16 * d0);
        const bf16_t* vb = Vt + ((size_t)(h * 256 + j) * 64 + ql) * 64 + 8 * hi;
#pragma unroll
        for (int dh = 0; dh < 2; ++dh)
#pragma unroll
            for (int ks = 0; ks < 4; ++ks) vf[dh * 4 + ks] = *(const bf16x8*)(vb + dh * 32 * 64 + 16 * ks);
        const float cqs = cq + sub;
        f32x16 p0, p1;
#pragma unroll
        for (int g = 0; g < 4; ++g) {
            const f32x4 c0 = *(const f32x4*)(lh + 64 * j + 8 * g + 4 * hi), c1 = *(const f32x4*)(lh + 64 * j + 32 + 8 * g + 4 * hi);
#pragma unroll
            for (int e = 0; e < 4; ++e) {
                float b0 = cqs - c0[e], b1 = cqs - c1[e];
                if (diag) { const int kv = 8 * g + 4 * hi + e; if (kv > qoff + ql) b0 = -INFINITY; if (kv + 32 > qoff + ql) b1 = -INFINITY; }
                p0[4 * g + e] = b0; p1[4 * g + e] = b1;
            }
        }
        attn_step<false>(st, qr, kf, vf, p0, p1, wsf, ql, hi);
    }
    attn_finish(st, OA + (size_t)q0 * 512 + h * 64, wsf, ql, hi);
}

__device__ __forceinline__ bf16x8 ldk_f32(const float* p) { const f32x4 a = *(const f32x4*)p, b = *(const f32x4*)(p + 4); return __builtin_bit_cast(bf16x8, pack8(a, b)); }
__device__ __forceinline__ bf16x8 ldv_f32(const float* p) {
    u32x4 w; w.x = cvtpk(p[0], p[512]); w.y = cvtpk(p[1024], p[1536]); w.z = cvtpk(p[8 * 512], p[9 * 512]); w.w = cvtpk(p[10 * 512], p[11 * 512]);
    return __builtin_bit_cast(bf16x8, w);
}
__device__ __forceinline__ void attn_sample_item(int b, int h, const bf16_t* Qb, const float* ck, const float* cv, const float* clf, const float* out, bf16_t* OA, LAS float* wsf, int lane) {
    const int ql = lane & 31, hi = lane >> 5;
    bf16x8 qr[4];
    { const bf16_t* qp = Qb + (size_t)(SEQ + b * 32 + ql) * 512 + h * 64 + 8 * hi;
#pragma unroll
      for (int d0 = 0; d0 < 4; ++d0) qr[d0] = *(const bf16x8*)(qp + 16 * d0); }
    float cq = out[O_LFS + (size_t)(b * 32 + ql) * 8 + h] * LOG2E;
#pragma unroll
    for (int o = 1; o < 32; o <<= 1) { const float t = __shfl_up(cq, o, 32); if (ql >= o) cq += t; }
    AttnSt st; st.m = -INFINITY; st.l = 0.f;
#pragma unroll
    for (int r = 0; r < 16; ++r) { st.o0[r] = 0.f; st.o1[r] = 0.f; }
    bf16x8 kf[8], vf[8];
    {
        if (hi == 0) wsf[ql] = cq;
        asm volatile("s_waitcnt lgkmcnt(0)" ::: "memory");
        f32x16 p0, p1;
#pragma unroll
        for (int g = 0; g < 4; ++g) {
            const f32x4 c0 = *(const LAS f32x4*)(wsf + 8 * g + 4 * hi);
#pragma unroll
            for (int e = 0; e < 4; ++e) { const int kv = 8 * g + 4 * hi + e; p0[4 * g + e] = (kv > ql) ? -INFINITY : cq - c0[e]; p1[4 * g + e] = 0.f; }
        }
        asm volatile("s_waitcnt lgkmcnt(0)" ::: "memory");
        const float* kb = out + O_KS + ((size_t)(b * 32 + ql) * 8 + h) * 64 + 8 * hi;
        const float* vb = out + O_VS + ((size_t)(b * 32 + 4 * hi) * 8 + h) * 64 + ql;
#pragma unroll
        for (int d0 = 0; d0 < 4; ++d0) kf[d0] = ldk_f32(kb + 16 * d0);
#pragma unroll
        for (int dh = 0; dh < 2; ++dh)
#pragma unroll
            for (int ks = 0; ks < 2; ++ks) vf[dh * 4 + ks] = ldv_f32(vb + dh * 32 + (size_t)ks * 16 * 512);
        attn_step<true>(st, qr, kf, vf, p0, p1, wsf, ql, hi);
    }
    float carry = 0.f;
    for (int j = PAST / 64 - 1; j >= 0; --j) {
        const float lfc = clf[((size_t)b * PAST + 64 * j + lane) * 8 + h] * LOG2E;
        float inc = lfc;
#pragma unroll
        for (int o = 1; o < 64; o <<= 1) { const float t = __shfl_down(inc, o); if (lane + o < 64) inc += t; }
        wsf[64 + lane] = inc - lfc + carry;
        carry += __shfl(inc, 0);
        asm volatile("s_waitcnt lgkmcnt(0)" ::: "memory");
#pragma unroll 1
        for (int half = 1; half >= 0; --half) {
            f32x16 p0, p1;
#pragma unroll
            for (int g = 0; g < 4; ++g) {
                const f32x4 c0 = *(const LAS f32x4*)(wsf + 64 + 32 * half + 8 * g + 4 * hi);
#pragma unroll
                for (int e = 0; e < 4; ++e) { p0[4 * g + e] = cq + c0[e]; p1[4 * g + e] = 0.f; }
            }
            const float* kb = ck + (((size_t)b * PAST + 64 * j + 32 * half + ql) * 8 + h) * 64 + 8 * hi;
            const float* vb = cv + (((size_t)b * PAST + 64 * j + 32 * half + 4 * hi) * 8 + h) * 64 + ql;
#pragma unroll
            for (int d0 = 0; d0 < 4; ++d0) kf[d0] = ldk_f32(kb + 16 * d0);
#pragma unroll
            for (int dh = 0; dh < 2; ++dh)
#pragma unroll
                for (int ks = 0; ks < 2; ++ks) vf[dh * 4 + ks] = ldv_f32(vb + dh * 32 + (size_t)ks * 16 * 512);
            attn_step<true>(st, qr, kf, vf, p0, p1, wsf, ql, hi);
        }
    }
    attn_finish(st, OA + (size_t)(SEQ + b * 32) * 512 + h * 64, wsf, ql, hi);
}


constexpr int AT_SLOT = 17408, AT_V = 8192, AT_X = 16384;
#define AT_WAITV(n) asm volatile("s_waitcnt vmcnt(" #n ") lgkmcnt(0)" ::: "memory")
__device__ __forceinline__ void attn_prompt_block(int qb, int h, const bf16_t* Qb, const bf16_t* Kb, const bf16_t* Vt, const u32x4* KX, const float* LH2, const float* TT2,
                                                  const float* hnQ, const float* hnK, bf16_t* OA, LAS unsigned char* lds, LAS float* wsf, LAS float* offs, int wave, int lane) {
    const int ql = lane & 31, hi = lane >> 5, wh = wave >> 1;
    const int q0 = 256 * qb + 32 * wave, qoff = (32 * wave) & 63;
    bf16x8 qr[4];
    { const bf16_t* qp = Qb + (size_t)(q0 + ql) * 512 + h * 64 + 8 * hi;
#pragma unroll
      for (int d0 = 0; d0 < 4; ++d0) qr[d0] = *(const bf16x8*)(qp + 16 * d0); }
    const float* lh = LH2 + (size_t)h * SEQ;
    const float cq = lh[q0 + ql];
    float nbL;
    { const int ta = 2 * qb, tb2 = 2 * qb + 1;
      const float qa = sqrtf(fmaxf(hnQ[(ta * 8 + h) * 2], hnQ[(tb2 * 8 + h) * 2])), qbn = sqrtf(fmaxf(hnQ[(ta * 8 + h) * 2 + 1], hnQ[(tb2 * 8 + h) * 2 + 1]));
      const float kda = sqrtf(fmaxf(hnK[(ta * 8 + h) * 2], hnK[(tb2 * 8 + h) * 2])), kdb = sqrtf(fmaxf(hnK[(ta * 8 + h) * 2 + 1], hnK[(tb2 * 8 + h) * 2 + 1]));
      float ka = fmaxf(hnK[(lane * 8 + h) * 2], hnK[((lane + 64) * 8 + h) * 2]), kb = fmaxf(hnK[(lane * 8 + h) * 2 + 1], hnK[((lane + 64) * 8 + h) * 2 + 1]);
      ka = sqrtf(wave_max(ka)); kb = sqrtf(wave_max(kb));
      nbL = 1.02f * (qa * (ka + kda) + qbn * (kb + kdb)) + 2.0f + lh[256 * qb]; }
    const float tb0 = TT2[(4 * qb) * 8 + h], tb1 = TT2[(4 * qb + 1) * 8 + h], tb2v = TT2[(4 * qb + 2) * 8 + h];
    const float pre1 = tb0, pre2 = tb0 + tb1, pre3 = pre2 + tb2v;
    const float prew = (wh == 0) ? 0.f : (wh == 1) ? pre1 : (wh == 2) ? pre2 : pre3;
    int count = 4 * qb;
    { float carry = 0.f;
      for (int base = 0; base < 4 * qb; base += 64) {
          const int i = base + lane, j = 4 * qb - 1 - i;
          const float tt = (j >= 0) ? TT2[j * 8 + h] : 0.f;
          float inc = tt;
#pragma unroll
          for (int o = 1; o < 64; o <<= 1) { const float t = __shfl_up(inc, o); if (lane >= o) inc += t; }
          const float sexcl = inc - tt + carry;
          const bool cond = (j < 0) || (nbL + sexcl < -152.f);
          if (j >= 0) offs[i] = inc + carry;
          const unsigned long long bal = __ballot(cond);
          if (bal) { count = base + (int)__ffsll((long long)bal) - 1; break; }
          carry += __shfl(inc, 63);
      } }
    const int NT = 4 + count, jmax = 4 * qb + 3;
    const int r8 = 8 * wave + (lane >> 3), cc = (lane & 7) ^ ((r8 >> 1) & 7);
    const bf16_t* ksrc = Kb + (size_t)r8 * 512 + h * 64 + 8 * cc;
    const bf16_t* vsrc = Vt + ((size_t)(h * 256) * 64 + r8) * 64 + 8 * cc;
    const u32x4* xsrc = KX + (size_t)h * SEQ + lane;
    const int swz = (ql >> 1) & 7;
    int fo[4];
#pragma unroll
    for (int d0 = 0; d0 < 4; ++d0) fo[d0] = ql * 128 + 16 * ((2 * d0 + hi) ^ swz);
#define AT_DMA(tt_) do { const int j_ = jmax - (tt_); LAS unsigned char* sl_ = lds + ((tt_) % 3) * AT_SLOT; \
        __builtin_amdgcn_global_load_lds((const unsigned*)(ksrc + (size_t)j_ * 64 * 512), (LAS unsigned*)(sl_ + wave * 1024), 16, 0, 0); \
        __builtin_amdgcn_global_load_lds((const unsigned*)(vsrc + (size_t)j_ * 4096), (LAS unsigned*)(sl_ + AT_V + wave * 1024), 16, 0, 0); \
        if (wave == 0) __builtin_amdgcn_global_load_lds((const unsigned*)(xsrc + (size_t)j_ * 64), (LAS unsigned*)(sl_ + AT_X), 16, 0, 0); } while (0)
    AT_DMA(0); AT_DMA(1);
    AttnSt st; st.m = -INFINITY; st.l = 0.f;
#pragma unroll
    for (int r = 0; r < 16; ++r) { st.o0[r] = 0.f; st.o1[r] = 0.f; }
    bf16x8 qx;
#pragma unroll
    for (int e = 0; e < 8; ++e) qx[e] = (hi == 0 && e < 2) ? (short)0xBF80 : (short)0;
    const bf16x8 zero8 = (bf16x8){0, 0, 0, 0, 0, 0, 0, 0};
    const int jd = 4 * qb + wh;
    for (int t = 0; t < NT; ++t) {
        if (t + 1 < NT) { if (wave == 0) AT_WAITV(3); else AT_WAITV(2); } else AT_WAITV(0);
        __builtin_amdgcn_s_barrier();
        if (t + 2 < NT) AT_DMA(t + 2);
        const int j = jmax - t;
        if (j > jd) continue;
        float off;
        if (t < 4) { const int kk = 3 - t; const float prek = (kk == 0) ? 0.f : (kk == 1) ? pre1 : (kk == 2) ? pre2 : pre3; off = prew - prek; }
        else off = prew + offs[t - 4];
        const float cqs = cq + off;
        const LAS unsigned char* sl = lds + (t % 3) * AT_SLOT;
        f32x16 p0, p1;
        if (j == jd) {
#pragma unroll
            for (int r = 0; r < 16; ++r) { const int kv = crow(r, hi); p0[r] = (kv > qoff + ql) ? -INFINITY : cqs; p1[r] = (kv + 32 > qoff + ql) ? -INFINITY : cqs; }
        } else {
#pragma unroll
            for (int r = 0; r < 16; ++r) { p0[r] = cqs; p1[r] = cqs; }
        }
        { bf16x8 x0 = *(const LAS bf16x8*)(sl + AT_X + 16 * ql), x1 = *(const LAS bf16x8*)(sl + AT_X + 16 * (ql + 32));
          if (hi) { x0 = zero8; x1 = zero8; }
          p0 = MFMA32(x0, qx, p0); p1 = MFMA32(x1, qx, p1); }
        bf16x8 kf[8], vf[8];
#pragma unroll
        for (int half = 0; half < 2; ++half)
#pragma unroll
            for (int d0 = 0; d0 < 4; ++d0) { kf[half * 4 + d0] = *(const LAS bf16x8*)(sl + half * 4096 + fo[d0]); vf[half * 4 + d0] = *(const LAS bf16x8*)(sl + AT_V + half * 4096 + fo[d0]); }
        attn_step<false>(st, qr, kf, vf, p0, p1, wsf, ql, hi);
    }
#undef AT_DMA
    attn_finish(st, OA + (size_t)q0 * 512 + h * 64, wsf, ql, hi);
}

__device__ __forceinline__ void attn_sample_block(int b, int h, const bf16_t* Qb, const float* ck, const float* cv, const float* clf, const float* out, bf16_t* OA,
                                                  LAS unsigned char* lds, LAS float* wsf, int wave, int lane, int tid) {
    const int ql = lane & 31, hi = lane >> 5;
    bf16x8 qr[4];
    { const bf16_t* qp = Qb + (size_t)(SEQ + b * 32 + ql) * 512 + h * 64 + 8 * hi;
#pragma unroll
      for (int d0 = 0; d0 < 4; ++d0) qr[d0] = *(const bf16x8*)(qp + 16 * d0); }
    float cq = out[O_LFS + (size_t)(b * 32 + ql) * 8 + h] * LOG2E;
#pragma unroll
    for (int o = 1; o < 32; o <<= 1) { const float t = __shfl_up(cq, o, 32); if (ql >= o) cq += t; }
    LAS float* segt = (LAS float*)(lds + 68608);
    const int s0 = 128 * wave;
    const float lf0 = clf[((size_t)b * PAST + s0 + 2 * lane) * 8 + h] * LOG2E, lf1 = clf[((size_t)b * PAST + s0 + 2 * lane + 1) * 8 + h] * LOG2E;
    float inc = lf0 + lf1;
#pragma unroll
    for (int o = 1; o < 64; o <<= 1) { const float t = __shfl_down(inc, o); if (lane + o < 64) inc += t; }
    if (lane == 0) segt[wave] = inc;
    __syncthreads();
    float carry = 0.f;
#pragma unroll
    for (int w2 = 1; w2 < 8; ++w2) if (w2 > wave) carry += segt[w2];
    { const float s1 = inc - lf0 - lf1 + carry; *(LAS f32x2*)(wsf + 128 + 2 * lane) = (f32x2){s1 + lf1, s1}; }
    asm volatile("s_waitcnt lgkmcnt(0)" ::: "memory");
    AttnSt st; st.m = -INFINITY; st.l = 0.f;
#pragma unroll
    for (int r = 0; r < 16; ++r) { st.o0[r] = 0.f; st.o1[r] = 0.f; }
    bf16x8 kf[8], vf[8];
#pragma unroll 1
    for (int ht = 3; ht >= 0; --ht) {
        f32x16 p0, p1;
#pragma unroll
        for (int g = 0; g < 4; ++g) {
            const f32x4 c0 = *(const LAS f32x4*)(wsf + 128 + 32 * ht + 8 * g + 4 * hi);
#pragma unroll
            for (int e = 0; e < 4; ++e) { p0[4 * g + e] = cq + c0[e]; p1[4 * g + e] = 0.f; }
        }
        const float* kb = ck + (((size_t)b * PAST + s0 + 32 * ht + ql) * 8 + h) * 64 + 8 * hi;
        const float* vb = cv + (((size_t)b * PAST + s0 + 32 * ht + 4 * hi) * 8 + h) * 64 + ql;
#pragma unroll
        for (int d0 = 0; d0 < 4; ++d0) kf[d0] = ldk_f32(kb + 16 * d0);
#pragma unroll
        for (int dh = 0; dh < 2; ++dh)
#pragma unroll
            for (int ks = 0; ks < 2; ++ks) vf[dh * 4 + ks] = ldv_f32(vb + dh * 32 + (size_t)ks * 16 * 512);
        attn_step<true>(st, qr, kf, vf, p0, p1, wsf, ql, hi);
    }
    if (wave == 7) {
        if (hi == 0) wsf[ql] = cq;
        asm volatile("s_waitcnt lgkmcnt(0)" ::: "memory");
        f32x16 p0, p1;
#pragma unroll
        for (int g = 0; g < 4; ++g) {
            const f32x4 c0 = *(const LAS f32x4*)(wsf + 8 * g + 4 * hi);
#pragma unroll
            for (int e = 0; e < 4; ++e) { const int kv = 8 * g + 4 * hi + e; p0[4 * g + e] = (kv > ql) ? -INFINITY : cq - c0[e]; p1[4 * g + e] = 0.f; }
        }
        asm volatile("s_waitcnt lgkmcnt(0)" ::: "memory");
        const float* kb = out + O_KS + ((size_t)(b * 32 + ql) * 8 + h) * 64 + 8 * hi;
        const float* vb = out + O_VS + ((size_t)(b * 32 + 4 * hi) * 8 + h) * 64 + ql;
#pragma unroll
        for (int d0 = 0; d0 < 4; ++d0) kf[d0] = ldk_f32(kb + 16 * d0);
#pragma unroll
        for (int dh = 0; dh < 2; ++dh)
#pragma unroll
            for (int ks = 0; ks < 2; ++ks) vf[dh * 4 + ks] = ldv_f32(vb + dh * 32 + (size_t)ks * 16 * 512);
        attn_step<true>(st, qr, kf, vf, p0, p1, wsf, ql, hi);
    }
    LAS float* po = (LAS float*)(lds + wave * 8448);
    const float lt = st.l + __shfl_xor(st.l, 32);
#pragma unroll
    for (int r = 0; r < 16; ++r) { po[crow(r, hi) * 64 + ql] = st.o0[r]; po[crow(r, hi) * 64 + 32 + ql] = st.o1[r]; }
    if (hi == 0) { po[2048 + ql] = st.m; po[2080 + ql] = lt; }
    __syncthreads();
    { const int q = tid >> 4, d4 = (tid & 15) * 4;
      float mw[8], M = -INFINITY;
#pragma unroll
      for (int w2 = 0; w2 < 8; ++w2) { mw[w2] = ((const LAS float*)(lds + w2 * 8448))[2048 + q]; M = fmaxf(M, mw[w2]); }
      float L = 0.f; f32x4 O = (f32x4){0.f, 0.f, 0.f, 0.f};
#pragma unroll
      for (int w2 = 0; w2 < 8; ++w2) { const LAS float* pw = (const LAS float*)(lds + w2 * 8448); const float wg = __builtin_amdgcn_exp2f(mw[w2] - M);
          L += wg * pw[2080 + q]; O = O + *(const LAS f32x4*)(pw + q * 64 + d4) * wg; }
      const float inv = 1.0f / L;
      u32x2 w; w.x = cvtpk(O[0] * inv, O[1] * inv); w.y = cvtpk(O[2] * inv, O[3] * inv);
      *(u32x2*)(OA + (size_t)(SEQ + b * 32 + q) * 512 + h * 64 + d4) = w; }
    __syncthreads();
}

constexpr int PL_STRIDE = 136;
template <int W>
__device__ __forceinline__ void pool_fill(int rt, int g, const float* P, const float* state_pool, LAS bf16_t* At, int tid) {
    const int cq = tid & 31, rg = tid >> 5;
    const int row0 = rt * 128 + 8 * rg, col = g * 128 + 4 * cq;
    const bool prompt = rt < 128;
    const float* pb; const float* hb; int nh;
    if (prompt) { pb = P + (size_t)row0 * 512 + col; hb = nullptr; nh = row0; }
    else { const int rs = row0 - SEQ, b = rs >> 5, tl0 = rs & 31; pb = P + (size_t)row0 * 512 + col; hb = state_pool + (size_t)(b * 15 + 15 + tl0) * 512 + col; nh = tl0; }
    auto ld = [&](int rr) -> f32x4 {
        if (rr + nh >= 0) return *(const f32x4*)(pb + (ptrdiff_t)rr * 512);
        if (hb) return *(const f32x4*)(hb + (ptrdiff_t)rr * 512);
        return (f32x4){0.f, 0.f, 0.f, 0.f};
    };
    f32x4 s = ld(-(W - 1));
#pragma unroll
    for (int i = 1; i < W - 1; ++i) s = s + ld(i - (W - 1));
    f32x4 cur = ld(0);
    s = s + cur;
#pragma unroll
    for (int i = 0; i < 8; ++i) {
        if (i > 0) { cur = ld(i); s = s + (cur - ld(i - W)); }
        float cnt = (float)W;
        if (prompt) { const int t = row0 + i; cnt = (float)((t + 1 < W) ? (t + 1) : W); }
        const f32x4 d = s * __builtin_amdgcn_rcpf(cnt) - cur;
        u32x2 w; w.x = cvtpk(d[0], d[1]); w.y = cvtpk(d[2], d[3]);
        *(LAS u32x2*)(At + (8 * rg + i) * PL_STRIDE + 4 * cq) = w;
    }
}
__device__ __forceinline__ void pool_item(int rt, int g, const float* P, const float* state_pool, const bf16_t* Wpg, const float* pool_scale, bf16_t* OP, LAS unsigned char* lds, int tid) {
    LAS bf16_t* At = (LAS bf16_t*)lds; LAS bf16_t* Bt = At + 128 * PL_STRIDE;
    if (g == 0) pool_fill<2>(rt, g, P, state_pool, At, tid);
    else if (g == 1) pool_fill<4>(rt, g, P, state_pool, At, tid);
    else if (g == 2) pool_fill<8>(rt, g, P, state_pool, At, tid);
    else pool_fill<16>(rt, g, P, state_pool, At, tid);
#pragma unroll
    for (int i = 0; i < 4; ++i) { const int idx = tid + 512 * i, n = idx >> 4, kc = (idx & 15) * 8;
        *(LAS u32x4*)(Bt + n * PL_STRIDE + kc) = *(const u32x4*)(Wpg + (size_t)g * 16384 + n * 128 + kc); }
    __syncthreads();
    const int wid = tid >> 6, lane = tid & 63, ql = lane & 31, hi = lane >> 5;
    const int r0 = 32 * (wid & 3), c0 = 64 * (wid >> 2);
    f32x16 a0, a1;
#pragma unroll
    for (int r = 0; r < 16; ++r) { a0[r] = 0.f; a1[r] = 0.f; }
#pragma unroll
    for (int ks = 0; ks < 8; ++ks) {
        const bf16x8 af = *(const LAS bf16x8*)(At + (r0 + ql) * PL_STRIDE + 16 * ks + 8 * hi);
        const bf16x8 b0 = *(const LAS bf16x8*)(Bt + (c0 + ql) * PL_STRIDE + 16 * ks + 8 * hi);
        const bf16x8 b1 = *(const LAS bf16x8*)(Bt + (c0 + 32 + ql) * PL_STRIDE + 16 * ks + 8 * hi);
        a0 = MFMA32(af, b0, a0); a1 = MFMA32(af, b1, a1);
    }
    const float s0 = pool_scale[g * 128 + c0 + ql], s1 = pool_scale[g * 128 + c0 + 32 + ql];
#pragma unroll
    for (int r = 0; r < 16; ++r) {
        bf16_t* o = OP + (size_t)(rt * 128 + r0 + crow(r, hi)) * 512 + g * 128 + c0 + ql;
        o[0] = cvt1(a0[r] * s0); o[32] = cvt1(a1[r] * s1);
    }
    __syncthreads();
}

__device__ __forceinline__ void tr_item(const float* W, int ldw, int Kdim, bf16_t* WT, int drow0, int k0, int n0src, LAS float* scr, int lane) {
#pragma unroll 8
    for (int i = 0; i < 32; ++i) { const int kk = 2 * i + (lane >> 5); scr[kk * 33 + (lane & 31)] = W[(size_t)(k0 + kk) * ldw + n0src + (lane & 31)]; }
    asm volatile("s_waitcnt lgkmcnt(0)" ::: "memory");
    const int c = lane & 7;
#pragma unroll
    for (int j = 0; j < 4; ++j) { const int n = (lane >> 3) + 8 * j; const LAS float* s = scr + (8 * c) * 33 + n;
        u32x4 o; o.x = cvtpk(s[0 * 33], s[1 * 33]); o.y = cvtpk(s[2 * 33], s[3 * 33]); o.z = cvtpk(s[4 * 33], s[5 * 33]); o.w = cvtpk(s[6 * 33], s[7 * 33]);
        *(u32x4*)(WT + (size_t)(drow0 + n) * Kdim + k0 + 8 * c) = o; }
    asm volatile("s_waitcnt lgkmcnt(0)" ::: "memory");
}

#define XB_TMO      128
#define XB_XCNT(j)  (256  + 64 * (j))
#define XB_XSUB(j)  (1280 + 64 * (j))
#define XB_XGEN(j)  (2304 + 64 * (j))
#define XB_TOP      3328
#define XB_TOPGEN   3392
#define XCD_BAR_WORDS 3456
#define XB_SPIN_CAP (1u << 22)
#define BAR_MAGIC 0x5EEDBA55u
__device__ __forceinline__ unsigned xb_ld(unsigned* p)              { return __hip_atomic_load(p, __ATOMIC_RELAXED, __HIP_MEMORY_SCOPE_AGENT); }
__device__ __forceinline__ unsigned xb_add(unsigned* p, unsigned v) { return __hip_atomic_fetch_add(p, v, __ATOMIC_RELAXED, __HIP_MEMORY_SCOPE_AGENT); }
__device__ __forceinline__ unsigned xb_xcc_id() { return (unsigned)__builtin_amdgcn_s_getreg((3 << 11) | 20) & 0xFu; }
#define XB_SPIN(cond, bar) do { unsigned _sp = 0; while (cond) { __builtin_amdgcn_s_sleep(1); \
    if ((++_sp & 255u) == 0u) { if (xb_ld(&(bar)[XB_TMO])) break; if (_sp > XB_SPIN_CAP) { atomicAdd(&(bar)[XB_TMO], 1u); break; } } } } while (0)
struct XcdBarrier { unsigned* bar; unsigned x; volatile LAS unsigned* st; };
__device__ __forceinline__ XcdBarrier xcd_barrier_post(unsigned* bar, volatile LAS unsigned* st) {
    XcdBarrier b; b.bar = bar; b.x = xb_xcc_id(); b.st = st;
    if (threadIdx.x == 0) (void)xb_add(&bar[XB_XCNT(b.x)], 1u);
    return b;
}
__device__ __forceinline__ void xcd_barrier_complete(unsigned* bar, unsigned x, unsigned& nloc, unsigned& nx) {
    const unsigned G = gridDim.x * gridDim.y * gridDim.z;
    unsigned sum, cnt, mine, sp = 0u;
    for (;;) {
        sum = 0u; cnt = 0u; mine = 0u;
#pragma unroll
        for (unsigned j = 0; j < 16; ++j) { const unsigned c = xb_ld(&bar[XB_XCNT(j)]); sum += c; cnt += (c > 0u) ? 1u : 0u; mine = (j == x) ? c : mine; }
        if (sum == G) break;
        __builtin_amdgcn_s_sleep(1);
        if ((++sp & 255u) == 0u) { if (xb_ld(&bar[XB_TMO])) break; if (sp > XB_SPIN_CAP) { atomicAdd(&bar[XB_TMO], 1u); break; } }
    }
    nloc = mine > 0u ? mine : 1u; nx = cnt > 0u ? cnt : 1u;
}
__device__ __forceinline__ void xcd_barrier(const XcdBarrier& b) {
    asm volatile("s_waitcnt vmcnt(0)" ::: "memory");
    __syncthreads();
    if (threadIdx.x == 0) {
        unsigned* bar = b.bar;
        __builtin_amdgcn_s_waitcnt(0);
        unsigned nloc = b.st[0], nx = b.st[1];
        if (nloc == 0u) { xcd_barrier_complete(bar, b.x, nloc, nx); b.st[0] = nloc; b.st[1] = nx; }
        const unsigned old = xb_add(&bar[XB_XSUB(b.x)], 1u);
        const unsigned gen = old / nloc;
        if (old + 1u == (gen + 1u) * nloc) {
            __builtin_amdgcn_fence(__ATOMIC_RELEASE, "agent");
            asm volatile("s_waitcnt vmcnt(0)" ::: "memory");
            const unsigned og = xb_add(&bar[XB_TOP], 1u);
            const unsigned tg = og / nx;
            if (og + 1u == (tg + 1u) * nx) xb_add(&bar[XB_TOPGEN], 1u);
            else XB_SPIN(xb_ld(&bar[XB_TOPGEN]) == tg, bar);
            __builtin_amdgcn_fence(__ATOMIC_ACQUIRE, "agent");
            xb_add(&bar[XB_XGEN(b.x)], 1u);
            asm volatile("s_waitcnt vmcnt(0)" ::: "memory");
        } else {
            XB_SPIN(xb_ld(&bar[XB_XGEN(b.x)]) == gen, bar);
            __builtin_amdgcn_fence(__ATOMIC_ACQUIRE, "agent");
            asm volatile("s_waitcnt vmcnt(0)" ::: "memory");
        }
    }
    __syncthreads();
}

struct Params {
    const float* in[20];
    float* out;
    unsigned char* ws;
    int ph_lo, ph_hi;
};

constexpr int LDS_BYTES = 147456;
constexpr int NTHREADS = 512;

__global__ void __launch_bounds__(NTHREADS, 2) fwd_kernel(Params p) {
    extern __shared__ __attribute__((aligned(16))) unsigned char lds_raw[];
    LAS unsigned char* lds = (LAS unsigned char*)lds_raw;
    const int tid = threadIdx.x, lane = tid & 63, wave = __builtin_amdgcn_readfirstlane(tid >> 6);
    const int G = gridDim.x, bx = blockIdx.x;
    unsigned* barw = (unsigned*)(p.ws + WS_BAR);
    volatile LAS unsigned* bst = (volatile LAS unsigned*)(lds + LDS_BYTES - 64);
    XcdBarrier xbar; xbar.bar = barw; xbar.x = 0; xbar.st = bst;
    if (p.ph_lo == -12345) cg::this_grid().sync();
    unsigned* startw = (unsigned*)(p.ws + WS_BAR + 16384);
    if (p.ph_hi - p.ph_lo > 1) {
        if (tid < 2) bst[tid] = 0u;
        if (bx == 0) {
            for (int i = tid; i < XCD_BAR_WORDS; i += NTHREADS) barw[i] = 0u;
            asm volatile("s_waitcnt vmcnt(0)" ::: "memory"); __syncthreads();
            if (tid == 0) { __builtin_amdgcn_fence(__ATOMIC_RELEASE, "agent"); asm volatile("s_waitcnt vmcnt(0)" ::: "memory"); __hip_atomic_store(startw, BAR_MAGIC, __ATOMIC_RELAXED, __HIP_MEMORY_SCOPE_AGENT); }
        } else if (tid == 0) {
            while (__hip_atomic_load(startw, __ATOMIC_RELAXED, __HIP_MEMORY_SCOPE_AGENT) != BAR_MAGIC) __builtin_amdgcn_s_sleep(2);
            __builtin_amdgcn_fence(__ATOMIC_ACQUIRE, "agent");
        }
        __syncthreads();
        xbar = xcd_barrier_post(barw, bst);
    }
    const int gw = bx * 8 + wave, NGW = G * 8;
    unsigned char* ws = p.ws; float* out = p.out;
    const float* x_prompt = p.in[0]; const float* x_sample = p.in[1]; const float* cache_k = p.in[2]; const float* cache_v = p.in[3];
    const float* cache_logf = p.in[4]; const float* state_pool = p.in[5]; const float* norm_mix = p.in[6]; const float* w_in = p.in[7];
    const float* b_forget = p.in[8]; const float* w_pool_group = p.in[9]; const float* pool_scale = p.in[10]; const float* w_branch_pool = p.in[11];
    const float* w_branch_attn = p.in[12]; const float* b_gate = p.in[13]; const float* w_out = p.in[14]; const float* norm_ffn = p.in[15];
    const float* w_ffn_gate = p.in[16]; const float* w_ffn_up = p.in[17]; const float* w_ffn_down = p.in[18]; const float* norm_final = p.in[19];
    float* hnQ = (float*)(ws + WS_CTL + CTL_HNQ); float* hnK = (float*)(ws + WS_CTL + CTL_HNK);
    float* rss1 = (float*)(ws + WS_CTL + CTL_RSS1); float* rss2 = (float*)(ws + WS_CTL + CTL_RSS2);
    unsigned* ctr = (unsigned*)(ws + WS_CTL + CTL_CTR); unsigned* flag3 = ctr + 16; unsigned* flag4 = ctr + 32;
    bf16_t* X2b = (bf16_t*)(ws + WS_OP);
    float* PA = (float*)(ws + WS_Q); float* PB = (float*)(ws + WS_OP);
    float* TT2 = (float*)(ws + WS_TT); float* LH2 = (float*)(ws + WS_LH); u32x4* KX = (u32x4*)(ws + WS_KX);
    bf16_t* W1t = (bf16_t*)(ws + WS_W1); bf16_t* Wbp = (bf16_t*)(ws + WS_WBP); bf16_t* Wba = (bf16_t*)(ws + WS_WBA); bf16_t* Wo = (bf16_t*)(ws + WS_WO);
    bf16_t* Wgu = (bf16_t*)(ws + WS_WGU); bf16_t* Wd = (bf16_t*)(ws + WS_WD); bf16_t* Wpg = (bf16_t*)(ws + WS_WPG);
    bf16_t* XN = (bf16_t*)(ws + WS_XN); bf16_t* MG = (bf16_t*)(ws + WS_XN); bf16_t* Gt = (bf16_t*)(ws + WS_G); bf16_t* HN = (bf16_t*)(ws + WS_G);
    float* PART = (float*)(ws + WS_XN);
    float* Pf = (float*)(ws + WS_P); bf16_t* Qb = (bf16_t*)(ws + WS_Q); bf16_t* Kb = (bf16_t*)(ws + WS_K); bf16_t* Vt = (bf16_t*)(ws + WS_V);
    bf16_t* OP = (bf16_t*)(ws + WS_OP); bf16_t* OA = (bf16_t*)(ws + WS_OA); bf16_t* Tf = (bf16_t*)(ws + WS_T); bf16_t* HF = (bf16_t*)(ws + WS_HF);
    const int lo = p.ph_lo, hi_ph = p.ph_hi;
#define IN(k) (lo <= (k) && (k) < hi_ph)
#define SEAM(k) do { if (IN(k) && IN((k) + 1)) xcd_barrier(xbar); } while (0)

    if (IN(0)) {
        for (size_t i = (size_t)bx * NTHREADS + tid; i < CTL_ZERO_END / 4; i += (size_t)G * NTHREADS) ((unsigned*)(ws + WS_CTL))[i] = 0u;
        LAS float* wf = (LAS float*)(lds + 73728);
        for (int i = tid; i < 8192; i += NTHREADS) wf[i] = w_in[(size_t)(i >> 3) * DIN + 2048 + (i & 7)];
        LAS float* scr = (LAS float*)(lds + wave * 8704);
        constexpr int I1 = 16 * 128, I8 = 32;
        for (int it = gw; it < I1 + I8; it += NGW) {
            int r = it;
            if (r < I1) { const int kb = r / 128, nb = r % 128, n0 = 32 * nb; tr_item(w_in, DIN, 1024, W1t, n0, 64 * kb, n0 < 2048 ? n0 : n0 + 8, scr, lane); continue; } r -= I1;
            { const int g = r >> 3, kb = (r >> 2) & 1, nb = r & 3; tr_item(w_pool_group + (size_t)g * 16384, 128, 128, Wpg + (size_t)g * 16384, 32 * nb, 64 * kb, 32 * nb, scr, lane); }
        }
        __syncthreads();
        f32x4 wfa[4][4], wfb[4][4];
#pragma unroll
        for (int j = 0; j < 4; ++j)
#pragma unroll
            for (int e = 0; e < 4; ++e) { const LAS float* wp = wf + (4 * lane + 256 * j + e) * 8; wfa[j][e] = *(const LAS f32x4*)wp; wfb[j][e] = *(const LAS f32x4*)(wp + 4); }
        f32x4 nv[4];
        if (gw < MROWS) { const float* xr = (gw < SEQ) ? x_prompt + (size_t)gw * DM : x_sample + (size_t)(gw - SEQ) * DM;
#pragma unroll
            for (int j = 0; j < 4; ++j) nv[j] = *(const f32x4*)(xr + 4 * lane + 256 * j); }
        for (int m = gw; m < MROWS; m += NGW) {
            f32x4 v[4]; float ss = 0.f;
#pragma unroll
            for (int j = 0; j < 4; ++j) { v[j] = nv[j]; ss += (v[j][0] * v[j][0] + v[j][1] * v[j][1]) + (v[j][2] * v[j][2] + v[j][3] * v[j][3]); }
            { const int m2 = m + NGW;
              if (m2 < MROWS) { const float* xr = (m2 < SEQ) ? x_prompt + (size_t)m2 * DM : x_sample + (size_t)(m2 - SEQ) * DM;
#pragma unroll
                  for (int j = 0; j < 4; ++j) nv[j] = *(const f32x4*)(xr + 4 * lane + 256 * j); } }
            const float rstd = rsqrtf(wave_sum(ss) * (1.0f / DM) + EPS);
            float fl[8];
#pragma unroll
            for (int hh = 0; hh < 8; ++hh) fl[hh] = 0.f;
#pragma unroll
            for (int j = 0; j < 4; ++j) {
                const f32x4 gm = *(const f32x4*)(norm_mix + 4 * lane + 256 * j);
                v[j] = v[j] * rstd * gm;
                u32x2 w; w.x = cvtpk(v[j][0], v[j][1]); w.y = cvtpk(v[j][2], v[j][3]);
                *(u32x2*)(XN + (size_t)m * DM + 4 * lane + 256 * j) = w;
#pragma unroll
                for (int e = 0; e < 4; ++e) {
                    const f32x4 wa = wfa[j][e], wb = wfb[j][e];
                    fl[0] += v[j][e] * wa[0]; fl[1] += v[j][e] * wa[1]; fl[2] += v[j][e] * wa[2]; fl[3] += v[j][e] * wa[3];
                    fl[4] += v[j][e] * wb[0]; fl[5] += v[j][e] * wb[1]; fl[6] += v[j][e] * wb[2]; fl[7] += v[j][e] * wb[3];
                }
            }
            float mine = 0.f;
#pragma unroll
            for (int hh = 0; hh < 8; ++hh) { const float t = wave_sum(fl[hh]); if (lane == hh) mine = t; }
            if (lane < 8) {
                const float z = mine + b_forget[lane];
                const float lf = fminf(z, 0.f) - log1pf(expf(-fabsf(z)));
                if (m < SEQ) out[O_LFP + (size_t)m * 8 + lane] = lf; else out[O_LFS + (size_t)(m - SEQ) * 8 + lane] = lf;
            }
        }
        __syncthreads();
    }
    SEAM(0);

    if (IN(1)) {
        pg8::Gemm g{XN, W1t, MROWS, 4096, 1024, nullptr, nullptr}; pg8::StaticOrder S; S.init(MROWS, 4096, G, bx, 1024);
        Epi1 E{Pf, Qb, Kb, Vt, Gt, b_gate, out, (unsigned*)hnQ, (unsigned*)hnK};
        pg8::gemm_phase<Epi1, pg8::StaticOrder, true, true>(lds, g, S, E);
        {
            const int rem = 1088 % G; const bool helper = (rem == 0) || (bx >= rem);
            if (helper) {
                const int nh = (rem == 0) ? G : G - rem, hidx = (rem == 0) ? bx : bx - rem;
                for (int tile = hidx; tile < 256; tile += nh) {
                    float inc = out[O_LFP + (size_t)(64 * tile + lane) * 8 + wave] * LOG2E;
        #pragma unroll
                    for (int o = 1; o < 64; o <<= 1) { const float t = __shfl_up(inc, o); if (lane >= o) inc += t; }
                    LH2[(size_t)wave * SEQ + 64 * tile + lane] = inc;
                    { const unsigned hb = cvtpk(inc, 0.f) & 0xffffu; const float hf = __uint_as_float(hb << 16); const unsigned lb = cvtpk(inc - hf, 0.f) & 0xffffu;
                      KX[(size_t)wave * SEQ + 64 * tile + lane] = (u32x4){hb | (lb << 16), 0u, 0u, 0u}; }
                    if (lane == 63) TT2[tile * 8 + wave] = inc;
                }
                LAS float* scr = (LAS float*)(lds + wave * 8704);
                constexpr int I2 = 8 * 32, I3 = 8 * 32, I4 = 16 * 32, I5 = 16 * 88, I6 = 16 * 88, I7 = 44 * 32;
                for (int it = hidx * 8 + wave; it < I2 + I3 + I4 + I5 + I6 + I7; it += nh * 8) {
                    int r = it;
                    if (r < I2) { const int kb = r / 32, nb = r % 32; tr_item(w_branch_pool, 1024, 512, Wbp, 32 * nb, 64 * kb, 32 * nb, scr, lane); continue; } r -= I2;
                    if (r < I3) { const int kb = r / 32, nb = r % 32; tr_item(w_branch_attn, 1024, 512, Wba, 32 * nb, 64 * kb, 32 * nb, scr, lane); continue; } r -= I3;
                    if (r < I4) { const int kb = r / 32, nb = r % 32; tr_item(w_out, 1024, 1024, Wo, 32 * nb, 64 * kb, 32 * nb, scr, lane); continue; } r -= I4;
                    if (r < I5) { const int kb = r / 88, nb = r % 88, n0 = 32 * nb; tr_item(w_ffn_gate, DFF, 1024, Wgu, 256 * (n0 >> 7) + (n0 & 127), 64 * kb, n0, scr, lane); continue; } r -= I5;
                    if (r < I6) { const int kb = r / 88, nb = r % 88, n0 = 32 * nb; tr_item(w_ffn_up, DFF, 1024, Wgu, 256 * (n0 >> 7) + 128 + (n0 & 127), 64 * kb, n0, scr, lane); continue; } r -= I6;
                    { const int kb = r / 32, nb = r % 32; tr_item(w_ffn_down, 1024, DFF, Wd, 32 * nb, 64 * kb, 32 * nb, scr, lane); }
                }
            }
        }
    }
    SEAM(1);

    if (IN(2)) {
        LAS float* wsf = (LAS float*)(lds + 69632) + wave * 256;
        LAS unsigned* sitem = (LAS unsigned*)(lds + 69632 + 8 * 1024);
        for (int i3 = bx; i3 < 544; i3 += G) pool_item(i3 >> 2, i3 & 3, Pf, state_pool, Wpg, pool_scale, OP, lds, tid);
        LAS float* offs = (LAS float*)(lds + 80000);
        for (;;) {
            if (tid == 0) sitem[0] = atomicAdd(ctr, 1u);
            __syncthreads();
            const int item = (int)sitem[0];
            __syncthreads();
            if (item >= 768) break;
            const int tri = item / 3, rm = item - 3 * tri;
            if (rm == 0) attn_sample_block(tri >> 3, tri & 7, Qb, cache_k, cache_v, cache_logf, out, OA, lds, wsf, wave, lane, tid);
            else { const int i2 = 2 * tri + rm - 1, h = i2 & 7, qb256 = 63 - (i2 >> 3);
                   attn_prompt_block(qb256, h, Qb, Kb, Vt, KX, LH2, TT2, hnQ, hnK, OA, lds, wsf, offs, wave, lane); }
        }
    }
    SEAM(2);

    if (IN(3)) {
        { pg8::Gemm g{OP, Wbp, MROWS, 1024, 512, OA, Wba}; Order3a S; S.init(G, bx); Epi3<0> E{Tf, Gt, MG, PA}; pg8::gemm_phase<Epi3<0>, Order3a, true, true>(lds, g, S, E); }
        { pg8::Gemm g{OA, Wba, SEQ, 1024, 512, nullptr, nullptr}; pg8::StaticOrder S; S.init(SEQ, 1024, G, bx, 512); Epi3<1> E{Tf, Gt, MG, PA}; pg8::gemm_phase<Epi3<1>, pg8::StaticOrder, true, true>(lds, g, S, E); }
    }
    SEAM(3);

    if (IN(4)) {
        const int hb = G - 1 - bx, hgw = hb * 8 + wave;
        if (hgw < NSAMP) {
            const int r = hgw; const bf16_t* grow = Gt + (size_t)(SEQ + r) * 2048;
#pragma unroll
            for (int j = 0; j < 4; ++j) {
                const int c = 4 * lane + 256 * j;
                const f32x4 a = *(const f32x4*)(PA + (size_t)r * 1024 + c) + *(const f32x4*)(PA + (size_t)(NSAMP + r) * 1024 + c);
                const f32x4 bq = *(const f32x4*)(PA + (size_t)(2 * NSAMP + r) * 1024 + c) + *(const f32x4*)(PA + (size_t)(3 * NSAMP + r) * 1024 + c);
                const u32x2 ga = *(const u32x2*)(grow + c), gb = *(const u32x2*)(grow + 1024 + c);
                const float m0 = a[0] * __uint_as_float(ga.x << 16) + bq[0] * __uint_as_float(gb.x << 16), m1 = a[1] * __uint_as_float(ga.x & 0xffff0000u) + bq[1] * __uint_as_float(gb.x & 0xffff0000u);
                const float m2 = a[2] * __uint_as_float(ga.y << 16) + bq[2] * __uint_as_float(gb.y << 16), m3 = a[3] * __uint_as_float(ga.y & 0xffff0000u) + bq[3] * __uint_as_float(gb.y & 0xffff0000u);
                u32x2 w; w.x = cvtpk(m0, m1); w.y = cvtpk(m2, m3);
                st_wt64(MG + (size_t)(SEQ + r) * 1024 + c, w.x, w.y);
            }
        }
        if (hb * 8 < NSAMP) {
            asm volatile("s_waitcnt vmcnt(0)" ::: "memory"); __syncthreads();
            if (tid == 0) __hip_atomic_fetch_add(flag3, 8u, __ATOMIC_RELAXED, __HIP_MEMORY_SCOPE_AGENT);
        }
        pg8::Gemm g{MG, Wo, MROWS, 1024, 1024, nullptr, nullptr}; Order4 S; S.init(G, bx, flag3);
        Epi4 E{x_prompt, x_sample, out + O_Y, HN, norm_ffn, rss1, PB};
        pg8::gemm_phase<Epi4, Order4, true, true>(lds, g, S, E);
    }
    SEAM(4);

    if (IN(5)) {
        const int rem5 = 1496 % G; const bool fin = (rem5 == 0) || (bx >= rem5);
        const int nh5 = (rem5 == 0) ? G : G - rem5, hidx5 = (rem5 == 0) ? bx : bx - rem5;
        if (fin) for (int r = hidx5 * 8 + wave; r < NSAMP; r += nh5 * 8) {
            float ss = 0.f;
#pragma unroll
            for (int j = 0; j < 4; ++j) {
                const int c = 4 * lane + 256 * j;
                f32x4 v = *(const f32x4*)(x_sample + (size_t)r * 1024 + c);
#pragma unroll
                for (int ch = 0; ch < 4; ++ch) v = v + *(const f32x4*)(PB + (size_t)(ch * NSAMP + r) * 1024 + c);
                *(f32x4*)(out + O_Y + (size_t)(SEQ + r) * 1024 + c) = v;
                const f32x4 nw = *(const f32x4*)(norm_ffn + c);
                u32x2 w; w.x = cvtpk(v[0] * nw[0], v[1] * nw[1]); w.y = cvtpk(v[2] * nw[2], v[3] * nw[3]);
                st_wt64(HN + (size_t)(SEQ + r) * 1024 + c, w.x, w.y);
                ss += (v[0] * v[0] + v[1] * v[1]) + (v[2] * v[2] + v[3] * v[3]);
            }
            ss = wave_sum(ss);
            if (lane == 0) __hip_atomic_store((unsigned*)(rss1 + SEQ + r), __float_as_uint(ss), __ATOMIC_RELAXED, __HIP_MEMORY_SCOPE_AGENT);
        }
        if (fin && hidx5 < NSAMP / 8) {
            asm volatile("s_waitcnt vmcnt(0)" ::: "memory"); __syncthreads();
            if (tid == 0) __hip_atomic_fetch_add(flag4, 8u * (unsigned)((NSAMP / 8 - hidx5 + nh5 - 1) / nh5), __ATOMIC_RELAXED, __HIP_MEMORY_SCOPE_AGENT);
        }
        pg8::Gemm g{HN, Wgu, MROWS, 2 * DFF, 1024, nullptr, nullptr}; LAS float* lrs = (LAS float*)(lds + 131072 + 1024); Order5 S; S.init(G, bx, flag4, rss1, lrs);
        Epi5 E{HF, lrs, 0};
        pg8::gemm_phase<Epi5, Order5, true, true>(lds, g, S, E);
    }
    SEAM(5);

    if (IN(6)) {
        pg8::Gemm g{HF, Wd, MROWS, 1024, DFF, nullptr, nullptr}; Order6 S; S.init(G, bx);
        Epi6 E{out + O_Y, PART, X2b};
        pg8::gemm_phase<Epi6, Order6, true, true>(lds, g, S, E);
    }
    SEAM(6);

    if (IN(7)) {
        for (int m = gw; m < MROWS; m += NGW) {
            float* y = out + O_Y + (size_t)m * DM;
            f32x4 v[4]; float ss = 0.f;
            if (m < SEQ) {
#pragma unroll
                for (int j = 0; j < 4; ++j) { const u32x2 w = *(const u32x2*)(X2b + (size_t)m * DM + 4 * lane + 256 * j);
                    v[j] = (f32x4){__uint_as_float(w.x << 16), __uint_as_float(w.x & 0xffff0000u), __uint_as_float(w.y << 16), __uint_as_float(w.y & 0xffff0000u)}; }
            } else {
#pragma unroll
                for (int j = 0; j < 4; ++j) v[j] = *(const f32x4*)(y + 4 * lane + 256 * j);
            }
            if (m >= SEQ) {
                for (int ch = 0; ch < 11; ++ch) {
                    const float* pp = PART + (size_t)ch * (NSAMP * 1024) + (size_t)(m - SEQ) * 1024;
#pragma unroll
                    for (int j = 0; j < 4; ++j) v[j] = v[j] + *(const f32x4*)(pp + 4 * lane + 256 * j);
                }
            }
#pragma unroll
            for (int j = 0; j < 4; ++j) ss += (v[j][0] * v[j][0] + v[j][1] * v[j][1]) + (v[j][2] * v[j][2] + v[j][3] * v[j][3]);
            const float rstd = rsqrtf(wave_sum(ss) * (1.0f / DM) + EPS);
#pragma unroll
            for (int j = 0; j < 4; ++j) {
                const f32x4 gm = *(const f32x4*)(norm_final + 4 * lane + 256 * j);
                __builtin_nontemporal_store(v[j] * rstd * gm, (f32x4*)(y + 4 * lane + 256 * j));
            }
        }
    }
    if (p.ph_hi - p.ph_lo > 1 && bx == 0 && tid == 0) __hip_atomic_store(startw, 0u, __ATOMIC_RELAXED, __HIP_MEMORY_SCOPE_AGENT);
#undef IN
#undef SEAM
}

#ifndef N_LAUNCHES
#define N_LAUNCHES 1
#endif

extern "C" void kernel_launch(void* const* d_in, const int* in_sizes, int n_in, void* d_out, int out_size, void* d_ws, size_t ws_size, hipStream_t stream) {
    static int grid = 0;
    if (grid == 0) {
        int dev = 0, cus = 0, per_cu = 0;
        hipGetDevice(&dev);
        hipDeviceGetAttribute(&cus, hipDeviceAttributeMultiprocessorCount, dev);
        hipFuncSetAttribute((const void*)fwd_kernel, hipFuncAttributeMaxDynamicSharedMemorySize, LDS_BYTES);
        hipOccupancyMaxActiveBlocksPerMultiprocessor(&per_cu, (const void*)fwd_kernel, NTHREADS, LDS_BYTES);
        if (per_cu < 1) per_cu = 1;
        grid = cus * per_cu;
        (void)hipGetLastError();
    }
    Params p{};
    for (int i = 0; i < 20; ++i) p.in[i] = (const float*)d_in[i];
    p.out = (float*)d_out; p.ws = (unsigned char*)d_ws;
#if N_LAUNCHES == 1
    p.ph_lo = 0; p.ph_hi = 8;
    void* args[] = {&p};
    hipError_t e = hipLaunchCooperativeKernel((const void*)fwd_kernel, dim3(grid), dim3(NTHREADS), args, LDS_BYTES, stream);
    if (e != hipSuccess) fprintf(stderr, "cooperative launch failed: %s (grid %d)\n", hipGetErrorString(e), grid);
#else
    for (int k = 0; k < 8; ++k) {
        p.ph_lo = k; p.ph_hi = k + 1;
        hipLaunchKernelGGL(fwd_kernel, dim3(grid), dim3(NTHREADS), LDS_BYTES, stream, p);
    }
#endif
}
```
